# Optimizing an MI355X kernel written in HIP

```python
import math
import jax, jax.numpy as jnp
from jax import lax
import numpy as np

D_MODEL = 1024
BATCH = 4
SEQ = 4096
DEPTH = 4
DEC_BATCH = 32
DEC_SEQ = 8
PAST_LEN = 8192
PAGE_SIZE = 128

HEAD_DIM = 64
MIX_W = D_MODEL
D_A = MIX_W // 4
H_A = D_A // HEAD_DIM
D_B = MIX_W // 2
H_B = D_B // HEAD_DIM
SSM_GROUPS = 2
N_STATE = 128
CONV_W = 4
CONV_DIM = D_B + 2 * SSM_GROUPS * N_STATE
SSD_CHUNK = 128
D_C = MIX_W - D_A - D_B
SCONV_W = 3
D_FF = 4 * D_MODEL
DILATED_CONFIGS = ((128, 1), (512, 4), (2048, 16))
WIN_MAX = 2048
IN_COLS = 3 * D_A + D_B + CONV_DIM + H_B + 3 * D_C
EPS = 1e-6

kernel_name = "hymba_dilated_ssd_shortconv_decoder_step"


def rms_norm(x, g):
    x32 = x.astype(jnp.float32)
    y = x32 * lax.rsqrt(jnp.mean(x32 * x32, axis=-1, keepdims=True) + EPS)
    return (y * g.astype(jnp.float32)).astype(x.dtype)


def alibi_slopes():
    return 2.0 ** (-8.0 * jnp.arange(1, H_A + 1, dtype=jnp.float32) / H_A)


def causal_conv(u, prev, w):
    width = w.shape[0]
    L = u.shape[1]
    ext = jnp.concatenate([prev.astype(u.dtype), u], axis=1)
    out = ext[:, 0:L] * w[0]
    for k in range(1, width):
        out = out + ext[:, k:k + L] * w[k]
    return out, ext[:, L:]


def dilated_branch_prompt(q, k, v, win, dil, slopes):
    Bsz, T, H, E = q.shape
    L = T // dil
    span = win // dil
    blk = span
    Lp = -(-L // blk) * blk
    nb = Lp // blk

    def to_strided(t):
        t = t.reshape(Bsz, L, dil, H, E).transpose(0, 2, 1, 3, 4)
        t = jnp.pad(t, ((0, 0), (0, 0), (0, Lp - L), (0, 0), (0, 0)))
        return t.reshape(Bsz, dil, nb, blk, H, E)

    qs, ks, vs = to_strided(q), to_strided(k), to_strided(v)
    pad = ((0, 0), (0, 0), (1, 0), (0, 0), (0, 0), (0, 0))
    k_ext, v_ext = jnp.pad(ks, pad), jnp.pad(vs, pad)
    k_band = jnp.concatenate([k_ext[:, :, :-1], k_ext[:, :, 1:]], axis=3)
    v_band = jnp.concatenate([v_ext[:, :, :-1], v_ext[:, :, 1:]], axis=3)

    s = jnp.einsum('bdnqhe,bdnkhe->bdnhqk', qs, k_band) * (HEAD_DIM ** -0.5)
    qi = jnp.arange(blk)
    ki = jnp.arange(2 * blk)
    diff = blk + qi[:, None] - ki[None, :]
    key_valid = (jnp.arange(nb)[:, None, None] > 0) | (ki[None, None, :] >= blk)
    mask = (diff >= 0)[None] & (diff <= span)[None] & key_valid
    dist = (dil * diff).astype(jnp.float32)
    s = s - slopes[:, None, None] * dist
    s = jnp.where(mask[None, None, :, None], s, -jnp.inf)
    m = jnp.max(s, axis=-1, keepdims=True)
    p = jnp.exp(s - m)
    l = jnp.sum(p, axis=-1)
    o = jnp.einsum('bdnhqk,bdnkhe->bdnqhe', p, v_band)
    o = o / jnp.transpose(l, (0, 1, 2, 4, 3))[..., None]

    o = o.reshape(Bsz, dil, Lp, H, E)[:, :, :L].transpose(0, 2, 1, 3, 4).reshape(Bsz, T, H, E)

    def stat_back(t):
        t = jnp.transpose(t, (0, 1, 2, 4, 3)).reshape(Bsz, dil, Lp, H)[:, :, :L]
        return t.transpose(0, 2, 1, 3).reshape(Bsz, T, H)

    return o, stat_back(m[..., 0]), stat_back(l)


def dilated_branch_sample(q, k_all, v_all, win, dil, slopes, wb):
    S = q.shape[1]
    span = win // dil
    j = jnp.arange(span + 1)
    idx = wb + jnp.arange(S)[:, None] - dil * j[None, :]
    valid = idx >= 0
    idx_c = jnp.maximum(idx, 0)
    kg = k_all[:, idx_c]
    vg = v_all[:, idx_c]
    s = jnp.einsum('bshe,bsjhe->bhsj', q, kg) * (HEAD_DIM ** -0.5)
    s = s - slopes[:, None, None] * (dil * j).astype(jnp.float32)[None, None, :]
    s = jnp.where(valid[None, None], s, -jnp.inf)
    m = jnp.max(s, axis=-1, keepdims=True)
    p = jnp.exp(s - m)
    l = jnp.sum(p, axis=-1)
    o = jnp.einsum('bhsj,bsjhe->bshe', p, vg)
    o = o / jnp.transpose(l, (0, 2, 1))[..., None]
    return o, jnp.transpose(m[..., 0], (0, 2, 1)), jnp.transpose(l, (0, 2, 1))


def merge_branches(results):
    os_ = jnp.stack([r[0] for r in results])
    ms = jnp.stack([r[1] for r in results])
    ls = jnp.stack([r[2] for r in results])
    m_all = jnp.max(ms, axis=0, keepdims=True)
    wts = ls * jnp.exp(ms - m_all)
    return jnp.sum(wts[..., None] * os_, axis=0) / jnp.sum(wts, axis=0)[..., None]


def ssd_scan(x, dt, a, bm, cm, h0, chunk):
    Bsz, L, H, P = x.shape
    G, N = bm.shape[2], bm.shape[3]
    nc = L // chunk
    f32 = jnp.float32
    x = x.astype(f32).reshape(Bsz, nc, chunk, H, P)
    dt = dt.reshape(Bsz, nc, chunk, H)
    bh = jnp.repeat(bm.astype(f32), H // G, axis=2).reshape(Bsz, nc, chunk, H, N)
    ch = jnp.repeat(cm.astype(f32), H // G, axis=2).reshape(Bsz, nc, chunk, H, N)
    acs = jnp.cumsum(dt * a, axis=2)
    causal = jnp.tril(jnp.ones((chunk, chunk), dtype=bool))
    seg = acs[:, :, :, None, :] - acs[:, :, None, :, :]
    decay = jnp.exp(jnp.where(causal[None, None, :, :, None], seg, -jnp.inf))
    scores = jnp.einsum('bclhn,bcshn->bclsh', ch, bh) * decay
    y_diag = jnp.einsum('bclsh,bcshp->bclhp', scores * dt[:, :, None, :, :], x)
    to_end = jnp.exp(acs[:, :, -1:, :] - acs)
    states = jnp.einsum('bclhn,bclhp->bchpn', bh * (to_end * dt)[..., None], x)
    chunk_decay = jnp.exp(acs[:, :, -1, :])

    def step(h, inp):
        dec, st = inp
        return dec[:, :, None, None] * h + st, h

    h_final, h_start = lax.scan(step, h0.astype(f32),
                                (jnp.moveaxis(chunk_decay, 1, 0), jnp.moveaxis(states, 1, 0)))
    h_start = jnp.moveaxis(h_start, 0, 1)
    y_off = jnp.einsum('bclhn,bchpn->bclhp', ch * jnp.exp(acs)[..., None], h_start)
    return (y_diag + y_off).reshape(Bsz, L, H, P), h_final


def token_mixer(h, w_in, w_out, attn_norm, conv_w, conv_b, a_log, dt_bias, d_skip, ssm_norm,
                sconv_w, sconv_norm, prev, prompt):
    Bsz, L, _ = h.shape
    dtype = h.dtype
    proj = h @ w_in
    cuts = list(np.cumsum([D_A, D_A, D_A, D_B, CONV_DIM, H_B, D_C, D_C]))
    q, k, v, z, xbc, dt_raw, b_gate, c_gate, u_c = jnp.split(proj, [int(c) for c in cuts], axis=-1)
    q = q.reshape(Bsz, L, H_A, HEAD_DIM).astype(jnp.float32)
    k = k.reshape(Bsz, L, H_A, HEAD_DIM)
    v = v.reshape(Bsz, L, H_A, HEAD_DIM)
    slopes = alibi_slopes()

    if prompt:
        res = [dilated_branch_prompt(q, k.astype(jnp.float32), v.astype(jnp.float32), w, d, slopes)
               for (w, d) in DILATED_CONFIGS]
        wb = min(WIN_MAX, L)
        new_k, new_v = k[:, L - wb:], v[:, L - wb:]
        h0 = jnp.zeros((Bsz, H_B, HEAD_DIM, N_STATE), jnp.float32)
        conv_prev = jnp.zeros((Bsz, CONV_W - 1, CONV_DIM), dtype)
        sconv_prev = jnp.zeros((Bsz, SCONV_W - 1, D_C), dtype)
    else:
        buf_k, buf_v, h0, conv_prev, sconv_prev = prev
        wb = buf_k.shape[1]
        k_all = jnp.concatenate([buf_k.astype(dtype), k], axis=1)
        v_all = jnp.concatenate([buf_v.astype(dtype), v], axis=1)
        res = [dilated_branch_sample(q, k_all.astype(jnp.float32), v_all.astype(jnp.float32),
                                     w, d, slopes, wb) for (w, d) in DILATED_CONFIGS]
        new_k, new_v = k_all[:, L:], v_all[:, L:]
    o_a = rms_norm(merge_branches(res).astype(dtype).reshape(Bsz, L, D_A), attn_norm)

    xbc_c, new_conv = causal_conv(xbc, conv_prev, conv_w)
    xbc_c = jax.nn.silu(xbc_c + conv_b)
    x_s, bm, cm = jnp.split(xbc_c, [D_B, D_B + SSM_GROUPS * N_STATE], axis=-1)
    dt = jax.nn.softplus(dt_raw.astype(jnp.float32) + dt_bias.astype(jnp.float32))
    a = -jnp.exp(a_log.astype(jnp.float32))
    x4 = x_s.reshape(Bsz, L, H_B, HEAD_DIM)
    chunk = min(SSD_CHUNK, L) if prompt else L
    y, h_new = ssd_scan(x4, dt, a, bm.reshape(Bsz, L, SSM_GROUPS, N_STATE),
                        cm.reshape(Bsz, L, SSM_GROUPS, N_STATE), h0, chunk)
    y = y + d_skip.astype(jnp.float32)[:, None] * x4.astype(jnp.float32)
    y_b = rms_norm(y.astype(dtype).reshape(Bsz, L, D_B) * jax.nn.silu(z), ssm_norm)

    conv_out, new_sconv = causal_conv(c_gate * u_c, sconv_prev, sconv_w)
    y_c = rms_norm(b_gate * conv_out, sconv_norm)

    out = jnp.concatenate([o_a, y_b, y_c], axis=-1) @ w_out
    return out, (new_k, new_v, h_new, new_conv, new_sconv)


def run_trunk(x, states, weights, prompt):
    (norm_mix_pre, norm_mix_post, norm_mlp_pre, norm_mlp_post, w_in, w_out, attn_norm,
     ssm_conv_w, ssm_conv_b, ssm_a_log, ssm_dt_bias, ssm_d, ssm_norm, sconv_w, sconv_norm,
     w_mlp_up, w_mlp_down) = weights
    per_layer = []
    for l in range(DEPTH):
        prev = None if prompt else tuple(s[l] for s in states)
        h = rms_norm(x, norm_mix_pre[l])
        mix, new = token_mixer(h, w_in[l], w_out[l], attn_norm[l], ssm_conv_w[l], ssm_conv_b[l],
                               ssm_a_log[l], ssm_dt_bias[l], ssm_d[l], ssm_norm[l], sconv_w[l],
                               sconv_norm[l], prev, prompt)
        x = x + rms_norm(mix, norm_mix_post[l])
        h = rms_norm(x, norm_mlp_pre[l])
        f = jnp.square(jax.nn.relu(h @ w_mlp_up[l])) @ w_mlp_down[l]
        x = x + rms_norm(f, norm_mlp_post[l])
        per_layer.append(new)
    stacked = tuple(jnp.stack([ns[i] for ns in per_layer]) for i in range(5))
    return x, stacked


def setup_inputs(seed: int = 0) -> dict:
    key = jax.random.key(seed)
    ks = jax.random.split(key, 24)
    f32 = jnp.float32

    def nrm(k, shape, scale):
        return scale * jax.random.normal(k, shape, f32)

    def gain(k, shape):
        return 1.0 + 0.02 * jax.random.normal(k, shape, f32)

    win_buf = min(WIN_MAX, PAST_LEN)
    dt0 = jnp.exp(jax.random.uniform(ks[17], (DEPTH, H_B), f32, math.log(1e-3), math.log(1e-1)))
    return {
        "x_prompt": nrm(ks[0], (BATCH, SEQ, D_MODEL), 1.0),
        "x_sample": nrm(ks[1], (DEC_BATCH, DEC_SEQ, D_MODEL), 1.0),
        "cache_attn_k": nrm(ks[2], (DEPTH, DEC_BATCH, win_buf, H_A, HEAD_DIM), 1.0),
        "cache_attn_v": nrm(ks[3], (DEPTH, DEC_BATCH, win_buf, H_A, HEAD_DIM), 1.0),
        "state_ssm": nrm(ks[4], (DEPTH, DEC_BATCH, H_B, HEAD_DIM, N_STATE), 0.1),
        "state_ssm_conv": nrm(ks[5], (DEPTH, DEC_BATCH, CONV_W - 1, CONV_DIM), 1.0),
        "state_sconv": nrm(ks[6], (DEPTH, DEC_BATCH, SCONV_W - 1, D_C), 1.0),
        "norm_mix_pre": gain(ks[7], (DEPTH, D_MODEL)),
        "norm_mix_post": gain(ks[8], (DEPTH, D_MODEL)),
        "norm_mlp_pre": gain(ks[9], (DEPTH, D_MODEL)),
        "norm_mlp_post": gain(ks[10], (DEPTH, D_MODEL)),
        "w_in": nrm(ks[11], (DEPTH, D_MODEL, IN_COLS), D_MODEL ** -0.5),
        "w_out": nrm(ks[12], (DEPTH, MIX_W, D_MODEL), MIX_W ** -0.5),
        "attn_norm": gain(ks[13], (DEPTH, D_A)),
        "ssm_conv_w": nrm(ks[14], (DEPTH, CONV_W, CONV_DIM), CONV_W ** -0.5),
        "ssm_conv_b": nrm(ks[15], (DEPTH, CONV_DIM), 0.01),
        "ssm_a_log": jnp.log(jax.random.uniform(ks[16], (DEPTH, H_B), f32, 1.0, 16.0)),
        "ssm_dt_bias": dt0 + jnp.log(-jnp.expm1(-dt0)),
        "ssm_d": gain(ks[18], (DEPTH, H_B)),
        "ssm_norm": gain(ks[19], (DEPTH, D_B)),
        "sconv_w": nrm(ks[20], (DEPTH, SCONV_W, D_C), SCONV_W ** -0.5),
        "sconv_norm": gain(ks[21], (DEPTH, D_C)),
        "w_mlp_up": nrm(ks[22], (DEPTH, D_MODEL, D_FF), D_MODEL ** -0.5),
        "w_mlp_down": nrm(ks[23], (DEPTH, D_FF, D_MODEL), D_FF ** -0.5),
    }


def reference(x_prompt, x_sample, cache_attn_k, cache_attn_v, state_ssm, state_ssm_conv,
              state_sconv, norm_mix_pre, norm_mix_post, norm_mlp_pre, norm_mlp_post, w_in, w_out,
              attn_norm, ssm_conv_w, ssm_conv_b, ssm_a_log, ssm_dt_bias, ssm_d, ssm_norm,
              sconv_w, sconv_norm, w_mlp_up, w_mlp_down):
    weights = (norm_mix_pre, norm_mix_post, norm_mlp_pre, norm_mlp_post, w_in, w_out, attn_norm,
               ssm_conv_w, ssm_conv_b, ssm_a_log, ssm_dt_bias, ssm_d, ssm_norm, sconv_w,
               sconv_norm, w_mlp_up, w_mlp_down)
    y_prompt, (p_k, p_v, p_ssm, p_conv, p_sconv) = run_trunk(x_prompt, None, weights, True)
    states = (cache_attn_k, cache_attn_v, state_ssm, state_ssm_conv, state_sconv)
    y_sample, (s_k, s_v, s_ssm, s_conv, s_sconv) = run_trunk(x_sample, states, weights, False)
    return (y_prompt, y_sample, p_k, p_v, p_ssm, p_conv, p_sconv, s_k, s_v, s_ssm, s_conv, s_sconv)
```

```cpp
#include <hip/hip_runtime.h>
#include <cstdio>
#include <cstdint>
namespace pg8 {
#define PG8_LAS __attribute__((address_space(3)))
typedef unsigned short bf16_t;
typedef short bf16x8 __attribute__((ext_vector_type(8)));
typedef float f32x4 __attribute__((ext_vector_type(4)));
typedef unsigned u32x4 __attribute__((ext_vector_type(4)));
constexpr int BM = 256, BK = 64, HALF = 128, HTB = HALF * BK * 2  , STAGE_BYTES = 8 * HTB, NXCD = 8, WGM = 8;

__host__ __device__ __forceinline__ int lds_byte(int r, int c) { const int st = (r >> 4) * 2 + (c >> 5), rr = r & 15, cc = c & 31, ob = rr * 64 + cc * 2; return st * 1024 + (ob ^ (((ob >> 9) & 1) << 5)); }
__host__ __device__ __forceinline__ void stage_rc(int b, int& R, int& C) { const int st = b / 1024, sb = b % 1024, swz = sb ^ (((sb >> 9) & 1) << 5); R = (st >> 1) * 16 + swz / 64; C = (st & 1) * 32 + (swz % 64) / 2; }
__host__ __device__ __forceinline__ int perm32(int rho) { const int n = rho >> 4, i = rho & 15; return 8 * (i >> 2) + 4 * n + (i & 3); }

struct Unit { int pm, pn; };
struct Gemm { const bf16_t* A; const bf16_t* Bt; int M, N, K; };

struct StaticOrder {
    int nM, nN, nwg, G, c;
    __host__ __device__ void init(int M, int N, int G_, int c_) { nM = M / BM; nN = N / BM; nwg = nM * nN; G = G_; c = c_; }
    __host__ __device__ bool next(int i, Unit& u) const {
        const long L = (long)i * G + c; if (L >= nwg) return false;
        int wgid = (int)L; { const int q = nwg / NXCD, r = nwg % NXCD, xcd = wgid % NXCD, off = wgid / NXCD; wgid = (xcd < r ? xcd * (q + 1) : r * (q + 1) + (xcd - r) * q) + off; }
        const int nig = WGM * nN, gid = wgid / nig, fm = gid * WGM, gsz = (nM - fm) < WGM ? (nM - fm) : WGM;
        u.pm = fm + ((wgid % nig) % gsz); u.pn = (wgid % nig) / gsz; return true;
    }
    __device__ __forceinline__ void a_ready(const Unit&) const {}
    __device__ __forceinline__ void done(const Unit&) const {}
};


__device__ __forceinline__ unsigned cvt_pk_bf16(float lo, float hi) { unsigned r; asm volatile("v_cvt_pk_bf16_f32 %0, %1, %2" : "=v"(r) : "v"(lo), "v"(hi)); return r; }
typedef float f32x2 __attribute__((ext_vector_type(2)));

template <int ACT  > struct EpiBf16 {
    static constexpr bool PERM = true, AFTER_DRAIN = false;
    bf16_t* O; int ldc;
    __device__ __forceinline__ void operator()(const f32x4 (&acc)[2][2][4][2], const Unit& u, int wr, int wc, int fr, int fq) const {
        const int row0 = u.pm * BM + wr * 64 + fr; const int col0 = u.pn * BM + wc * 32 + 8 * fq;
#pragma unroll
        for (int ai = 0; ai < 2; ++ai)
#pragma unroll
            for (int m = 0; m < 4; ++m) { bf16_t* rowp = O + (size_t)(row0 + ai * HALF + m * 16) * ldc + col0;
#pragma unroll
                for (int bj = 0; bj < 2; ++bj) { f32x4 v0 = acc[ai][bj][m][0], v1 = acc[ai][bj][m][1];
                    if (ACT == 2) {
#pragma unroll
                        for (int e = 0; e < 4; ++e) { float a = v0[e] > 0.f ? v0[e] : 0.f; v0[e] = a * a; float b = v1[e] > 0.f ? v1[e] : 0.f; v1[e] = b * b; } }
                    u32x4 w; w.x = cvt_pk_bf16(v0[0], v0[1]); w.y = cvt_pk_bf16(v0[2], v0[3]); w.z = cvt_pk_bf16(v1[0], v1[1]); w.w = cvt_pk_bf16(v1[2], v1[3]);
                    *(u32x4*)(rowp + bj * HALF) = w; } }
    }
};
struct EpiF32 {
    static constexpr bool PERM = false, AFTER_DRAIN = false;
    float* O; int ldc;
    __device__ __forceinline__ void operator()(const f32x4 (&acc)[2][2][4][2], const Unit& u, int wr, int wc, int fr, int fq) const {
        const int row0 = u.pm * BM + wr * 64 + fr; const int col0 = u.pn * BM + wc * 32 + 4 * fq;
#pragma unroll
        for (int ai = 0; ai < 2; ++ai)
#pragma unroll
            for (int m = 0; m < 4; ++m) { float* rowp = O + (size_t)(row0 + ai * HALF + m * 16) * ldc + col0;
#pragma unroll
                for (int bj = 0; bj < 2; ++bj)
#pragma unroll
                    for (int n = 0; n < 2; ++n) *(f32x4*)(rowp + bj * HALF + n * 16) = acc[ai][bj][m][n]; }
    }
};

template <class Epi, class Sched, bool ALIGN_EPI = false, bool SP2 = false>
__device__ __forceinline__ void gemm_phase(PG8_LAS unsigned char* lds, const Gemm g, const Sched& S, const Epi& E) {
    int tid_ = threadIdx.x; asm volatile("" : "+v"(tid_));
    const int tid = tid_, wid = __builtin_amdgcn_readfirstlane(tid >> 6), lane = tid & 63, wr = wid >> 2, wc = wid & 3, fr = lane & 15, fq = lane >> 4;
    const int K = g.K, nt = K / BK;
    unsigned voffA[2], voffB[2];
#pragma unroll
    for (int i = 0; i < 2; ++i) { int R, C; stage_rc(tid * 16 + i * 8192, R, C); const int Rb = Epi::PERM ? ((R & ~31) + perm32(R & 31)) : R;
        voffA[i] = (unsigned)(R * K + C) * 2u; voffB[i] = (unsigned)(Rb * K + C) * 2u; }
    const size_t kstep = (size_t)(BK * 2);
    const size_t hstep = (size_t)HALF * K * 2;
    const size_t tstep = 2 * hstep;
    const unsigned ldsw = (unsigned)wid * 1024u;
    const int aoff = lds_byte(wr * 64 + fr, fq * 8), boff = lds_byte(wc * 32 + fr, fq * 8);
#define PG8_SA(b, h) (((b) * 2 + (h)) * HTB)
#define PG8_SB(b, h) ((4 + (b) * 2 + (h)) * HTB)
#define PG8_STAGE(bufoff, gbase, voff) do { _Pragma("unroll") for (int _i = 0; _i < 2; ++_i) \
        __builtin_amdgcn_global_load_lds((const unsigned*)((const char*)(gbase) + (voff)[_i]), (PG8_LAS unsigned*)(lds + (bufoff) + ldsw + _i * 8192), 16, 0, 0); } while (0)
#define PG8_LDA(dst, b, h) do { _Pragma("unroll") for (int m = 0; m < 4; ++m) _Pragma("unroll") for (int k = 0; k < 2; ++k) dst[m][k] = *(const PG8_LAS bf16x8*)(lds + PG8_SA(b, h) + aoff + m * 2048 + k * 1024); } while (0)
#define PG8_LDB(dst, b, h) do { _Pragma("unroll") for (int n = 0; n < 2; ++n) _Pragma("unroll") for (int k = 0; k < 2; ++k) dst[n][k] = *(const PG8_LAS bf16x8*)(lds + PG8_SB(b, h) + boff + n * 2048 + k * 1024); } while (0)
#define PG8_MMA(ai, bj, At, Bt) do { __builtin_amdgcn_s_setprio(1); _Pragma("unroll") for (int m = 0; m < 4; ++m) _Pragma("unroll") for (int n = 0; n < 2; ++n) _Pragma("unroll") for (int k = 0; k < 2; ++k) \
        acc[ai][bj][m][n] = __builtin_amdgcn_mfma_f32_16x16x32_bf16(Bt[n][k], At[m][k], acc[ai][bj][m][n], 0, 0, 0); __builtin_amdgcn_s_setprio(0); } while (0)
#define PG8_WAIT_V(n) asm volatile("s_waitcnt vmcnt(" #n ")" ::: "memory")
#define PG8_WAIT_L(n) asm volatile("s_waitcnt lgkmcnt(" #n ")" ::: "memory")
#define PG8_BAR __builtin_amdgcn_s_barrier()
#define PG8_SCHED __builtin_amdgcn_sched_barrier(0)
    Unit cur, nxt; int ui = 0;
    if (!S.next(0, cur)) return;
    f32x4 acc[2][2][4][2];
#pragma unroll
    for (int a = 0; a < 2; ++a)
#pragma unroll
        for (int b = 0; b < 2; ++b)
#pragma unroll
            for (int m = 0; m < 4; ++m)
#pragma unroll
                for (int n = 0; n < 2; ++n) acc[a][b][m][n] = (f32x4){0.f, 0.f, 0.f, 0.f};
    bf16x8 At[4][2], B0[2][2], B1[2][2];
    const char* cA = (const char*)g.A + (size_t)cur.pm * tstep; const char* cB = (const char*)g.Bt + (size_t)cur.pn * tstep;
    S.a_ready(cur);
    if constexpr (SP2) {
        PG8_STAGE(PG8_SB(0, 0), cB, voffB); PG8_STAGE(PG8_SB(0, 1), cB + hstep, voffB); PG8_STAGE(PG8_SA(0, 0), cA, voffA); PG8_STAGE(PG8_SA(0, 1), cA + hstep, voffA);
        if (wr == 1) PG8_BAR;
        PG8_WAIT_V(2); PG8_BAR;
        PG8_STAGE(PG8_SB(1, 0), cB + kstep, voffB); PG8_STAGE(PG8_SA(1, 0), cA + kstep, voffA); PG8_STAGE(PG8_SB(1, 1), cB + hstep + kstep, voffB);
        PG8_WAIT_V(6); PG8_BAR;
    } else {
        PG8_STAGE(PG8_SB(0, 0), cB, voffB); PG8_STAGE(PG8_SA(0, 0), cA, voffA); PG8_STAGE(PG8_SB(0, 1), cB + hstep, voffB); PG8_STAGE(PG8_SA(0, 1), cA + hstep, voffA);
        if (wr == 1) PG8_BAR;
        PG8_WAIT_V(4); PG8_BAR;
        PG8_STAGE(PG8_SB(1, 0), cB + kstep, voffB); PG8_STAGE(PG8_SA(1, 0), cA + kstep, voffA); PG8_STAGE(PG8_SB(1, 1), cB + hstep + kstep, voffB);
        PG8_WAIT_V(6); PG8_BAR;
    }
    for (;;) {
        const bool has_next = S.next(ui + 1, nxt);
        const char* nA = has_next ? (const char*)g.A + (size_t)nxt.pm * tstep : cA; const char* nB = has_next ? (const char*)g.Bt + (size_t)nxt.pn * tstep : cB;
        for (int t = 0; t < nt; t += 2) {
            const bool last = (t == nt - 2);
            const char* a1 = cA + (size_t)(t + 1) * kstep;
            const char* a2 = last ? nA : cA + (size_t)(t + 2) * kstep; const char* b2 = last ? nB : cB + (size_t)(t + 2) * kstep;
            const char* a3 = a2 + kstep; const char* b3 = b2 + kstep;
            if (last && has_next) S.a_ready(nxt);
            if constexpr (SP2) {
            PG8_LDB(B0, 0, 0); PG8_LDB(B1, 0, 1); PG8_SCHED; PG8_LDA(At, 0, 0); PG8_STAGE(PG8_SA(1, 1), a1 + hstep, voffA);
            PG8_WAIT_V(8); PG8_WAIT_L(0); PG8_BAR; PG8_MMA(0, 0, At, B0); PG8_MMA(0, 1, At, B1); PG8_BAR; PG8_SCHED;
            PG8_LDA(At, 0, 1); PG8_STAGE(PG8_SB(0, 0), b2, voffB); PG8_STAGE(PG8_SB(0, 1), b2 + hstep, voffB); PG8_STAGE(PG8_SA(0, 0), a2, voffA);
            PG8_WAIT_V(8); PG8_WAIT_L(0); PG8_BAR; PG8_MMA(1, 0, At, B0); PG8_MMA(1, 1, At, B1); PG8_BAR; PG8_SCHED;
            PG8_LDB(B0, 1, 0); PG8_LDB(B1, 1, 1); PG8_SCHED; PG8_LDA(At, 1, 0); PG8_STAGE(PG8_SA(0, 1), a2 + hstep, voffA);
            PG8_WAIT_V(8); PG8_WAIT_L(0); PG8_BAR; PG8_MMA(0, 0, At, B0); PG8_MMA(0, 1, At, B1); PG8_BAR; PG8_SCHED;
            PG8_LDA(At, 1, 1); PG8_STAGE(PG8_SB(1, 0), b3, voffB); PG8_STAGE(PG8_SB(1, 1), b3 + hstep, voffB); PG8_STAGE(PG8_SA(1, 0), a3, voffA);
            PG8_WAIT_V(8); PG8_WAIT_L(0); PG8_BAR; PG8_MMA(1, 0, At, B0); PG8_MMA(1, 1, At, B1); PG8_BAR; PG8_SCHED;
            } else {
            PG8_LDB(B0, 0, 0); PG8_SCHED; PG8_LDA(At, 0, 0); PG8_STAGE(PG8_SA(1, 1), a1 + hstep, voffA);
            PG8_WAIT_L(8); PG8_BAR; PG8_WAIT_L(0); PG8_MMA(0, 0, At, B0); PG8_BAR; PG8_SCHED;
            PG8_LDB(B1, 0, 1); PG8_STAGE(PG8_SB(0, 0), b2, voffB);
            PG8_BAR; PG8_WAIT_L(0); PG8_MMA(0, 1, At, B1); PG8_BAR;
            PG8_LDA(At, 0, 1); PG8_STAGE(PG8_SA(0, 0), a2, voffA);
            PG8_BAR; PG8_WAIT_L(0); PG8_MMA(1, 0, At, B0); PG8_BAR; PG8_SCHED;
            PG8_STAGE(PG8_SB(0, 1), b2 + hstep, voffB);
            PG8_WAIT_V(6); PG8_BAR; PG8_MMA(1, 1, At, B1); PG8_BAR;
            PG8_LDB(B0, 1, 0); PG8_SCHED; PG8_LDA(At, 1, 0); PG8_STAGE(PG8_SA(0, 1), a2 + hstep, voffA);
            PG8_WAIT_L(8); PG8_BAR; PG8_WAIT_L(0); PG8_MMA(0, 0, At, B0); PG8_BAR; PG8_SCHED;
            PG8_LDB(B1, 1, 1); PG8_STAGE(PG8_SB(1, 0), b3, voffB);
            PG8_BAR; PG8_WAIT_L(0); PG8_MMA(0, 1, At, B1); PG8_BAR;
            PG8_LDA(At, 1, 1); PG8_STAGE(PG8_SA(1, 0), a3, voffA);
            PG8_BAR; PG8_WAIT_L(0); PG8_MMA(1, 0, At, B0); PG8_BAR; PG8_SCHED;
            PG8_STAGE(PG8_SB(1, 1), b3 + hstep, voffB);
            PG8_WAIT_V(6); PG8_BAR; PG8_MMA(1, 1, At, B1); PG8_BAR;
            }
        }
        if constexpr (ALIGN_EPI) { if (wr == 0) PG8_BAR; }
        if constexpr (!Epi::AFTER_DRAIN) { E(acc, cur, wr, wc, fr, fq); S.done(cur); }
        if (!has_next) break;
#pragma unroll
        for (int a = 0; a < 2; ++a)
#pragma unroll
            for (int b = 0; b < 2; ++b)
#pragma unroll
                for (int m = 0; m < 4; ++m)
#pragma unroll
                    for (int n = 0; n < 2; ++n) acc[a][b][m][n] = (f32x4){0.f, 0.f, 0.f, 0.f};
        cur = nxt; cA = nA; cB = nB; ++ui;
        if constexpr (ALIGN_EPI) { if (wr == 1) PG8_BAR; }
    }
    PG8_WAIT_V(0);
    if constexpr (!ALIGN_EPI) { if (wr == 0) PG8_BAR; }
    PG8_BAR;
    if constexpr (Epi::AFTER_DRAIN) { E.fused(acc, cur, wr, wc, fr, fq, lds, wid, lane); S.done(cur); }
#undef PG8_SA
#undef PG8_SB
#undef PG8_STAGE
#undef PG8_LDA
#undef PG8_LDB
#undef PG8_MMA
#undef PG8_WAIT_V
#undef PG8_WAIT_L
#undef PG8_BAR
#undef PG8_SCHED
}
}
#define GAS __attribute__((address_space(1)))
#define LAS __attribute__((address_space(3)))
typedef unsigned short bf16;
typedef unsigned v4u __attribute__((ext_vector_type(4)));
typedef float f32x4 __attribute__((ext_vector_type(4)));
typedef short bf16x8 __attribute__((ext_vector_type(8)));
typedef GAS unsigned gu32;
typedef GAS unsigned long long gu64;
#define RLX_AGENT __ATOMIC_RELAXED, __HIP_MEMORY_SCOPE_AGENT
#define LDS_WAIT() asm volatile("s_waitcnt lgkmcnt(0)" ::: "memory")
#define VM_WAIT() asm volatile("s_waitcnt vmcnt(0)" ::: "memory")
__device__ __forceinline__ unsigned long long rt() { return __builtin_amdgcn_s_memrealtime(); }
__device__ __forceinline__ unsigned f2bf(float f) { unsigned u = __builtin_bit_cast(unsigned, f); return (u + 0x7fffu + ((u >> 16) & 1u)) >> 16; }
__device__ __forceinline__ unsigned pk2(float lo, float hi) { return f2bf(lo) | (f2bf(hi) << 16); }

#define XB_TMO      128
#define XB_XCNT(j)  (256  + 64 * (j))
#define XB_XSUB(j)  (1280 + 64 * (j))
#define XB_XGEN(j)  (2304 + 64 * (j))
#define XB_TOP      3328
#define XB_TOPGEN   3392
#define XCD_BAR_WORDS 3456
#define XB_SPIN_CAP (1u << 18)

__device__ __forceinline__ unsigned xb_ld(unsigned* p)              { return __hip_atomic_load(p, __ATOMIC_RELAXED, __HIP_MEMORY_SCOPE_AGENT); }
__device__ __forceinline__ unsigned xb_add(unsigned* p, unsigned v) { return __hip_atomic_fetch_add(p, v, __ATOMIC_RELAXED, __HIP_MEMORY_SCOPE_AGENT); }
__device__ __forceinline__ unsigned xb_xcc_id() { return (unsigned)__builtin_amdgcn_s_getreg((3 << 11) | 20) & 0xFu; }
#define XB_SPIN(cond, bar) do { unsigned _sp = 0; while (cond) { __builtin_amdgcn_s_sleep(1); \
    if ((++_sp & 255u) == 0u) { if (xb_ld(&(bar)[XB_TMO])) break; if (_sp > XB_SPIN_CAP) { atomicAdd(&(bar)[XB_TMO], 1u); break; } } } } while (0)

struct XcdBarrier {
    unsigned* bar; unsigned x;
    volatile LAS unsigned* st;
};

__device__ __forceinline__ XcdBarrier xcd_barrier_post(unsigned* bar, volatile LAS unsigned* st) {
    XcdBarrier b; b.bar = bar; b.x = xb_xcc_id(); b.st = st;
    if (threadIdx.x == 0) (void)xb_add(&bar[XB_XCNT(b.x)], 1u);
    return b;
}
__device__ __forceinline__ void xcd_barrier_complete(unsigned* bar, unsigned x, unsigned& nloc, unsigned& nx) {
    const unsigned G = gridDim.x * gridDim.y * gridDim.z;
    unsigned sum, cnt, mine, sp = 0u;
    for (;;) {
        sum = 0u; cnt = 0u; mine = 0u;
#pragma unroll
        for (unsigned j = 0; j < 16; ++j) { const unsigned c = xb_ld(&bar[XB_XCNT(j)]); sum += c; cnt += (c > 0u) ? 1u : 0u; mine = (j == x) ? c : mine; }
        if (sum == G) break;
        __builtin_amdgcn_s_sleep(1);
        if ((++sp & 255u) == 0u) { if (xb_ld(&bar[XB_TMO])) break; if (sp > XB_SPIN_CAP) { atomicAdd(&bar[XB_TMO], 1u); break; } }
    }
    nloc = mine > 0u ? mine : 1u; nx = cnt > 0u ? cnt : 1u;
}

__device__ __forceinline__ void xcd_barrier(const XcdBarrier& b) {
    asm volatile("s_waitcnt vmcnt(0)" ::: "memory");
    __syncthreads();
    if (threadIdx.x == 0) {
        unsigned* bar = b.bar;
        __builtin_amdgcn_s_waitcnt(0);
        unsigned nloc = b.st[0], nx = b.st[1];
        if (nloc == 0u) { xcd_barrier_complete(bar, b.x, nloc, nx); b.st[0] = nloc; b.st[1] = nx; }
        const unsigned old = xb_add(&bar[XB_XSUB(b.x)], 1u);
        const unsigned gen = old / nloc;
        if (old + 1u == (gen + 1u) * nloc) {
            __builtin_amdgcn_fence(__ATOMIC_RELEASE, "agent");
            asm volatile("s_waitcnt vmcnt(0)" ::: "memory");
            const unsigned og = xb_add(&bar[XB_TOP], 1u);
            const unsigned tg = og / nx;
            if (og + 1u == (tg + 1u) * nx) xb_add(&bar[XB_TOPGEN], 1u);
            else XB_SPIN(xb_ld(&bar[XB_TOPGEN]) == tg, bar);
            __builtin_amdgcn_fence(__ATOMIC_ACQUIRE, "agent");
            xb_add(&bar[XB_XGEN(b.x)], 1u);
            asm volatile("s_waitcnt vmcnt(0)" ::: "memory");
        } else {
            XB_SPIN(xb_ld(&bar[XB_XGEN(b.x)]) == gen, bar);
            __builtin_amdgcn_fence(__ATOMIC_ACQUIRE, "agent");
            asm volatile("s_waitcnt vmcnt(0)" ::: "memory");
        }
    }
    __syncthreads();
}

constexpr int NWAVES = 8, NTHR = 512;
constexpr int DM = 1024, NBATCH = 4, SEQ = 4096, DEPTH = 4, DBATCH = 32, DSEQ = 8, WBUF = 2048;
constexpr int HD = 64, NHA = 4, NHB = 8, NST = 128, DFF = 4096;
constexpr int TP = NBATCH * SEQ, TS = DBATCH * DSEQ, MT = TP + TS;
constexpr int INC = 3080, NPJ = 3072, WIN_ROWS = 3088;
constexpr int PC_Q = 0, PC_K = 256, PC_V = 512, PC_Z = 768, PC_XBC = 1280, PC_BG = 2304, PC_CG = 2560, PC_UC = 2816;
constexpr float EPS = 1e-6f, LOG2E = 1.4426950408889634f;

constexpr size_t O_Y = 0;
constexpr size_t O_PK = (size_t)MT * DM;
constexpr size_t SZ_PKV = (size_t)DEPTH * NBATCH * WBUF * 256;
constexpr size_t O_PV = O_PK + SZ_PKV;
constexpr size_t O_PSSM = O_PV + SZ_PKV;
constexpr size_t SZ_PSSM = (size_t)DEPTH * NBATCH * NHB * HD * NST;
constexpr size_t O_PCONV = O_PSSM + SZ_PSSM;
constexpr size_t SZ_PCONV = (size_t)DEPTH * NBATCH * 3 * 1024;
constexpr size_t O_PSC = O_PCONV + SZ_PCONV;
constexpr size_t SZ_PSC = (size_t)DEPTH * NBATCH * 2 * 256;
constexpr size_t O_SK = O_PSC + SZ_PSC;
constexpr size_t SZ_SKV = (size_t)DEPTH * DBATCH * WBUF * 256;
constexpr size_t O_SV = O_SK + SZ_SKV;
constexpr size_t O_SSSM = O_SV + SZ_SKV;
constexpr size_t SZ_SSSM = (size_t)DEPTH * DBATCH * NHB * HD * NST;
constexpr size_t O_SCONV = O_SSSM + SZ_SSSM;
constexpr size_t SZ_SCONV = (size_t)DEPTH * DBATCH * 3 * 1024;
constexpr size_t O_SSC = O_SCONV + SZ_SCONV;
constexpr size_t SZ_SSC = (size_t)DEPTH * DBATCH * 2 * 256;
constexpr size_t O_END = O_SSC + SZ_SSC;
static_assert(O_END == 177987584ull, "d_out size");

constexpr size_t MiB = 1u << 20;
constexpr size_t WS_CTL = 0, CTL_ZERO_BYTES = 1 * MiB;
constexpr size_t SZ_WIN = (size_t)WIN_ROWS * DM * 2, SZ_WOUT = (size_t)DM * DM * 2, SZ_WUP = (size_t)DFF * DM * 2, SZ_WDN = (size_t)DM * DFF * 2;
constexpr size_t WS_WIN = 1 * MiB;
constexpr size_t WS_WOUT = WS_WIN + DEPTH * SZ_WIN;
constexpr size_t WS_WUP = WS_WOUT + DEPTH * SZ_WOUT;
constexpr size_t WS_WDN = WS_WUP + DEPTH * SZ_WUP;
constexpr size_t WS_XN = WS_WDN + DEPTH * SZ_WDN;
constexpr size_t WS_PROJ = WS_XN + (size_t)MT * DM * 2;
constexpr size_t WS_CAT = WS_PROJ + (size_t)MT * NPJ * 2;
constexpr size_t WS_MIX = WS_CAT + (size_t)MT * DM * 2;
constexpr size_t WS_H = WS_MIX + (size_t)MT * DM * 4;
constexpr size_t WS_OPART = WS_H + (size_t)MT * DFF * 2;
constexpr size_t WS_MLM = WS_OPART + (size_t)MT * 768 * 2;
constexpr size_t WS_MLL = WS_MLM + (size_t)MT * 12 * 4;
constexpr size_t WS_DT = WS_MLL + (size_t)MT * 12 * 4;
constexpr size_t WS_SSQ = WS_DT + (size_t)MT * 8 * 4;
constexpr size_t WS_CD = WS_SSQ + (size_t)MT * 8 * 4;
constexpr size_t WS_STATES = WS_CD + 4096;
constexpr size_t SZ_STATES = (size_t)NBATCH * 32 * NHB * HD * NST * 4;
constexpr size_t WS_HST = WS_STATES + SZ_STATES;
constexpr size_t WS_END = WS_HST + SZ_STATES;
static_assert(WS_END < 900 * MiB, "d_ws map");
static_assert((WS_XN % 256) == 0 && (WS_PROJ % 256) == 0 && (WS_CAT % 256) == 0 && (WS_H % 256) == 0 && (WS_OPART % 256) == 0 && (WS_STATES % 256) == 0, "alignment");
constexpr int CW_TMO = 0, CW_CODE = 1;
constexpr int CW_BAR = 4096;

constexpr int RING_OFF = 0, RING_BYTES = 131072;
constexpr int LDSCTL_OFF = RING_BYTES, MISC_OFF = LDSCTL_OFF + 320;
constexpr int LDS_BYTES = 147456;
static_assert(MISC_OFF + 128 <= LDS_BYTES, "LDS map");

struct Frame {
    LAS unsigned char* lds;
    volatile LAS unsigned* MISC;
    gu32* ctl;
    int tid, lane, wave;
    int vcu, G;
};

__device__ __forceinline__ float bf2f(unsigned short u) { return __uint_as_float(((unsigned)u) << 16); }
__device__ __forceinline__ float bflo(unsigned w) { return __uint_as_float(w << 16); }
__device__ __forceinline__ float bfhi(unsigned w) { return __uint_as_float(w & 0xffff0000u); }
__device__ __forceinline__ unsigned short f2bf16(float f) { return (unsigned short)f2bf(f); }
__device__ __forceinline__ float wave_sum(float v) {
#pragma unroll
    for (int o = 1; o < 64; o <<= 1) v += __shfl_xor(v, o);
    return v;
}
__device__ __forceinline__ float wave_max(float v) {
#pragma unroll
    for (int o = 1; o < 64; o <<= 1) v = fmaxf(v, __shfl_xor(v, o));
    return v;
}
__device__ __forceinline__ float silu_f(float x) { return x / (1.f + __expf(-x)); }
__device__ __forceinline__ float softplus_f(float x) { return x > 20.f ? x : log1pf(__expf(x)); }
__device__ __forceinline__ void unpack8(const v4u w, float (&f)[8]) {
    f[0] = bflo(w.x); f[1] = bfhi(w.x); f[2] = bflo(w.y); f[3] = bfhi(w.y); f[4] = bflo(w.z); f[5] = bfhi(w.z); f[6] = bflo(w.w); f[7] = bfhi(w.w);
}

__device__ __forceinline__ void p0_transpose_item(const float* Wsrc, int pitch, int K, bf16* WT, int dst_row0, int nblk, LAS float* scr, int item, int lane) {
    const int kb = item / nblk, nb = item % nblk, k0 = 64 * kb, n0 = 32 * nb;
#pragma unroll 8
    for (int i = 0; i < 32; ++i) { const int kk = 2 * i + (lane >> 5); scr[kk * 33 + (lane & 31)] = Wsrc[(size_t)(k0 + kk) * pitch + n0 + (lane & 31)]; }
    LDS_WAIT(); asm volatile("" ::: "memory");
    const int c = lane & 7;
#pragma unroll
    for (int j = 0; j < 4; ++j) { const int n = (lane >> 3) + 8 * j; const LAS float* s = scr + (8 * c) * 33 + n;
        v4u o; o.x = pk2(s[0 * 33], s[1 * 33]); o.y = pk2(s[2 * 33], s[3 * 33]); o.z = pk2(s[4 * 33], s[5 * 33]); o.w = pk2(s[6 * 33], s[7 * 33]);
        *(GAS v4u*)(WT + (size_t)(dst_row0 + n0 + n) * K + k0 + 8 * c) = o; }
    LDS_WAIT(); asm volatile("" ::: "memory");
}

struct Ptrs {
    const float *x_prompt, *x_sample, *cache_k, *cache_v, *state_ssm, *state_conv, *state_sconv;
    const float *g_mix_pre, *g_mix_post, *g_mlp_pre, *g_mlp_post, *w_in, *w_out, *attn_norm, *conv_w, *conv_b, *a_log, *dt_bias, *ssm_d, *ssm_norm, *sconv_w, *sconv_norm, *w_up, *w_down;
    float* out; unsigned char* ws;
};

__device__ __forceinline__ void row_norm_to_bf16(const float* xrow, const float* g, bf16* orow, float* xcopy, int lane) {
    const GAS f32x4* xr = (const GAS f32x4*)xrow + lane;
    f32x4 v[4]; float s = 0.f;
#pragma unroll
    for (int j = 0; j < 4; ++j) { v[j] = xr[64 * j]; s += (v[j].x * v[j].x + v[j].y * v[j].y) + (v[j].z * v[j].z + v[j].w * v[j].w); }
    const float r = 1.f / sqrtf(wave_sum(s) * (1.f / DM) + EPS);
    if (xcopy) {
#pragma unroll
        for (int j = 0; j < 4; ++j) ((GAS f32x4*)xcopy + lane)[64 * j] = v[j];
    }
    GAS unsigned long long* o8 = (GAS unsigned long long*)orow + lane;
#pragma unroll
    for (int j = 0; j < 4; ++j) { const f32x4 gg = ((const GAS f32x4*)g + lane)[64 * j];
        o8[64 * j] = (unsigned long long)pk2(v[j].x * r * gg.x, v[j].y * r * gg.y) | ((unsigned long long)pk2(v[j].z * r * gg.z, v[j].w * r * gg.w) << 32); }
}

__device__ __forceinline__ void p0_prologue(Frame& F, const Ptrs& P) {
    LAS float* scr = (LAS float*)(F.lds + RING_OFF + F.wave * 16384);
    const int gw = F.vcu * NWAVES + F.wave, NGW = F.G * NWAVES;
    unsigned char* ws = P.ws;
    constexpr int I_A = 16 * 72, I_B = 16 * 24, I_O = 16 * 32, I_U = 16 * 128, I_D = 64 * 32, I_DT = 16, I_L = I_A + I_B + I_O + I_U + I_D + I_DT;
    for (int it = gw; it < DEPTH * I_L; it += NGW) {
        const int l = it / I_L; int r = it % I_L;
        const float* win = P.w_in + (size_t)l * DM * INC; bf16* wint = (bf16*)(ws + WS_WIN + (size_t)l * SZ_WIN);
        if (r < I_A) { p0_transpose_item(win, INC, DM, wint, 0, 72, scr, r, F.lane); continue; } r -= I_A;
        if (r < I_B) { p0_transpose_item(win + 2312, INC, DM, wint, 2304, 24, scr, r, F.lane); continue; } r -= I_B;
        if (r < I_O) { p0_transpose_item(P.w_out + (size_t)l * DM * DM, DM, DM, (bf16*)(ws + WS_WOUT + (size_t)l * SZ_WOUT), 0, 32, scr, r, F.lane); continue; } r -= I_O;
        if (r < I_U) { p0_transpose_item(P.w_up + (size_t)l * DM * DFF, DFF, DM, (bf16*)(ws + WS_WUP + (size_t)l * SZ_WUP), 0, 128, scr, r, F.lane); continue; } r -= I_U;
        if (r < I_D) { p0_transpose_item(P.w_down + (size_t)l * DFF * DM, DM, DFF, (bf16*)(ws + WS_WDN + (size_t)l * SZ_WDN), 0, 32, scr, r, F.lane); continue; } r -= I_D;
        bf16* dst = wint + (size_t)(NPJ + r) * DM;
        for (int k = F.lane; k < DM; k += 64) dst[k] = (r < 8) ? f2bf16(win[(size_t)k * INC + 2304 + r]) : (bf16)0;
    }
    float* X = P.out + O_Y; bf16* XN = (bf16*)(ws + WS_XN);
    for (int m = gw; m < MT; m += NGW) {
        const float* src = (m < TP) ? P.x_prompt + (size_t)m * DM : P.x_sample + (size_t)(m - TP) * DM;
        row_norm_to_bf16(src, P.g_mix_pre, XN + (size_t)m * DM, X + (size_t)m * DM, F.lane);
    }
    {
        constexpr size_t PER = (size_t)2040 * 256 / 4;
        const size_t total = (size_t)2 * DEPTH * DBATCH * PER;
        const size_t gt = (size_t)F.vcu * NTHR + F.tid, NT = (size_t)F.G * NTHR;
        for (size_t i = gt; i < total; i += NT) {
            const size_t lb = i / PER, off = i % PER; const int which = (int)(lb / (DEPTH * DBATCH)); const size_t lbi = lb % (DEPTH * DBATCH);
            const f32x4* src = (const f32x4*)((which ? P.cache_v : P.cache_k) + lbi * (size_t)WBUF * 256 + 8 * 256) + off;
            f32x4* dst = (f32x4*)(P.out + (which ? O_SV : O_SK) + lbi * (size_t)WBUF * 256) + off;
            const f32x4 v = __builtin_nontemporal_load(src); __builtin_nontemporal_store(v, dst);
        }
    }
}

__device__ __forceinline__ void dt_pass(Frame& F, const bf16* XN, const bf16* Wdt  , float* DT) {
    const int gw = F.vcu * NWAVES + F.wave, NGW = F.G * NWAVES, fr = F.lane & 15, g = F.lane >> 4;
    for (int it = gw; it < MT / 16; it += NGW) {
        const bf16* a = XN + (size_t)(16 * it + fr) * DM + 8 * g; const bf16* b = Wdt + (size_t)fr * DM + 8 * g;
        f32x4 acc = {0.f, 0.f, 0.f, 0.f};
#pragma unroll 8
        for (int s = 0; s < 32; ++s) { const bf16x8 av = *(const bf16x8*)(a + 32 * s), bv = *(const bf16x8*)(b + 32 * s); acc = __builtin_amdgcn_mfma_f32_16x16x32_bf16(av, bv, acc, 0, 0, 0); }
        if (fr < 8) {
#pragma unroll
            for (int r = 0; r < 4; ++r) DT[(size_t)(16 * it + 4 * g + r) * 8 + fr] = acc[r];
        }
    }
}

constexpr int AT_KS = 0, AT_KPITCH = 72, AT_VT = 256 * AT_KPITCH * 2, AT_VPITCH = 280, AT_PW = AT_VT + 64 * AT_VPITCH * 2, AT_PPITCH = 168, AT_PWB = 16 * AT_PPITCH * 2, AT_END = AT_PW + 8 * AT_PWB;
static_assert(AT_END <= RING_BYTES, "attention LDS");
__device__ __forceinline__ void attn_prompt_unit(Frame& F, int u, const bf16* PROJ, bf16* OPART, float* MLM, float* MLL) {
    const int tid = F.tid, lane = F.lane, w = F.wave, fr = lane & 15, g = lane >> 4;
    const int br = u >> 9, rem = u & 511, b = rem >> 7, h = (rem >> 5) & 3, blk = rem & 31;
    const int sh = 2 * br, dil = 1 << sh, rr = blk & (dil - 1), n = blk >> sh;
    const float slope = exp2f(-2.f * (float)(h + 1));
    const float bstep = slope * (float)dil * LOG2E;
    LAS bf16* Ks = (LAS bf16*)(F.lds + AT_KS); LAS bf16* Vt = (LAS bf16*)(F.lds + AT_VT); LAS bf16* Pw = (LAS bf16*)(F.lds + AT_PW + w * AT_PWB);
    __syncthreads();
#pragma unroll
    for (int i = 0; i < 4; ++i) {
        const int c = tid + 512 * i, row = c >> 3, c8 = c & 7;
        const int j = 128 * (n - 1) + row;
        v4u kv = {0u, 0u, 0u, 0u}, vv = {0u, 0u, 0u, 0u};
        if (j >= 0) { const size_t m = (size_t)b * SEQ + (size_t)j * dil + rr; const bf16* p = PROJ + m * NPJ + h * 64 + c8 * 8; kv = *(const GAS v4u*)(p + PC_K); vv = *(const GAS v4u*)(p + PC_V); }
        *(LAS v4u*)(Ks + row * AT_KPITCH + c8 * 8) = kv;
        LAS bf16* vd = Vt + (c8 * 8) * AT_VPITCH + row;
        vd[0 * AT_VPITCH] = (bf16)(vv.x & 0xffffu); vd[1 * AT_VPITCH] = (bf16)(vv.x >> 16); vd[2 * AT_VPITCH] = (bf16)(vv.y & 0xffffu); vd[3 * AT_VPITCH] = (bf16)(vv.y >> 16);
        vd[4 * AT_VPITCH] = (bf16)(vv.z & 0xffffu); vd[5 * AT_VPITCH] = (bf16)(vv.z >> 16); vd[6 * AT_VPITCH] = (bf16)(vv.w & 0xffffu); vd[7 * AT_VPITCH] = (bf16)(vv.w >> 16);
    }
#pragma unroll
    for (int i = 0; i < 3; ++i) { const int idx = tid + 512 * i, d = idx / 24, cc = idx % 24; Vt[d * AT_VPITCH + 256 + cc] = (bf16)0; }
    const size_t mq = (size_t)b * SEQ + (size_t)(128 * n + 16 * w + fr) * dil + rr;
    bf16x8 qf[2];
#pragma unroll
    for (int s = 0; s < 2; ++s) qf[s] = *(const GAS bf16x8*)(PROJ + mq * NPJ + PC_Q + h * 64 + 32 * s + 8 * g);
    __syncthreads();
    f32x4 sc[9];
#pragma unroll
    for (int kb = 0; kb < 9; ++kb) {
        f32x4 a = {0.f, 0.f, 0.f, 0.f};
#pragma unroll
        for (int s = 0; s < 2; ++s) { const bf16x8 kf = *(const LAS bf16x8*)(Ks + (16 * (w + kb) + fr) * AT_KPITCH + 32 * s + 8 * g); a = __builtin_amdgcn_mfma_f32_16x16x32_bf16(qf[s], kf, a, 0, 0, 0); }
        sc[kb] = a;
    }
    float mx[4] = {-INFINITY, -INFINITY, -INFINITY, -INFINITY};
#pragma unroll
    for (int kb = 0; kb < 9; ++kb) {
        const bool kvalid = (n > 0) || (16 * (w + kb) + fr >= 128);
#pragma unroll
        for (int r = 0; r < 4; ++r) {
            const int diff = 128 + 4 * g + r - 16 * kb - fr;
            const bool ok = kvalid && diff >= 0 && diff <= 128;
            const float v = ok ? (sc[kb][r] * (0.125f * LOG2E) - bstep * (float)diff) : -INFINITY;
            sc[kb][r] = v; mx[r] = fmaxf(mx[r], v);
        }
    }
#pragma unroll
    for (int r = 0; r < 4; ++r) {
#pragma unroll
        for (int o = 1; o < 16; o <<= 1) mx[r] = fmaxf(mx[r], __shfl_xor(mx[r], o));
    }
    float ls[4] = {0.f, 0.f, 0.f, 0.f};
#pragma unroll
    for (int kb = 0; kb < 9; ++kb) {
#pragma unroll
        for (int r = 0; r < 4; ++r) { const float p = exp2f(sc[kb][r] - mx[r]); ls[r] += p; Pw[(4 * g + r) * AT_PPITCH + 16 * kb + fr] = f2bf16(p); }
    }
#pragma unroll
    for (int r = 0; r < 4; ++r) {
        Pw[(4 * g + r) * AT_PPITCH + 144 + fr] = (bf16)0;
#pragma unroll
        for (int o = 1; o < 16; o <<= 1) ls[r] += __shfl_xor(ls[r], o);
    }
    f32x4 oa[4];
#pragma unroll
    for (int c = 0; c < 4; ++c) oa[c] = (f32x4){0.f, 0.f, 0.f, 0.f};
#pragma unroll
    for (int s = 0; s < 5; ++s) {
        const bf16x8 pf = *(const LAS bf16x8*)(Pw + fr * AT_PPITCH + 32 * s + 8 * g);
#pragma unroll
        for (int c = 0; c < 4; ++c) { const bf16x8 vf = *(const LAS bf16x8*)(Vt + (16 * c + fr) * AT_VPITCH + 16 * w + 32 * s + 8 * g); oa[c] = __builtin_amdgcn_mfma_f32_16x16x32_bf16(pf, vf, oa[c], 0, 0, 0); }
    }
#pragma unroll
    for (int r = 0; r < 4; ++r) {
        const size_t mo = (size_t)b * SEQ + (size_t)(128 * n + 16 * w + 4 * g + r) * dil + rr;
        const float il = 1.f / ls[r];
#pragma unroll
        for (int c = 0; c < 4; ++c) OPART[mo * 768 + br * 256 + h * 64 + 16 * c + fr] = f2bf16(oa[c][r] * il);
        if (fr == 0) { MLM[mo * 12 + br * 4 + h] = mx[r] * (1.f / LOG2E); MLL[mo * 12 + br * 4 + h] = ls[r]; }
    }
}

__device__ __forceinline__ void ssd_dt_acs(Frame& F, LAS float* fl, const float* DT, const float* dt_bias, const float* a_log, int m0, int g) {
    const int tid = F.tid, l = tid & 127, hh = tid >> 7, h = 4 * g + hh;
    const float dtv = softplus_f(DT[(size_t)(m0 + l) * 8 + h] + dt_bias[h]);
    const float a = -__expf(a_log[h]);
    float v = dtv * a;
#pragma unroll
    for (int o = 1; o < 64; o <<= 1) { const float t = __shfl_up(v, o); if (F.lane >= o) v += t; }
    LAS float* tot = fl + 1024;
    if (F.lane == 63) tot[F.wave] = v;
    __syncthreads();
    if (F.wave & 1) v += tot[F.wave - 1];
    fl[hh * 128 + l] = v; fl[512 + hh * 128 + l] = dtv;
    __syncthreads();
}
struct Conv8 { float w[4][8]; float bias[8]; };
__device__ __forceinline__ void conv8_load(Conv8& c, const float* conv_w  , const float* conv_b, int ch0) {
#pragma unroll
    for (int k = 0; k < 4; ++k) { const f32x4 a = *(const GAS f32x4*)(conv_w + k * 1024 + ch0), b = *(const GAS f32x4*)(conv_w + k * 1024 + ch0 + 4);
        c.w[k][0] = a.x; c.w[k][1] = a.y; c.w[k][2] = a.z; c.w[k][3] = a.w; c.w[k][4] = b.x; c.w[k][5] = b.y; c.w[k][6] = b.z; c.w[k][7] = b.w; }
    const f32x4 a = *(const GAS f32x4*)(conv_b + ch0), b = *(const GAS f32x4*)(conv_b + ch0 + 4);
    c.bias[0] = a.x; c.bias[1] = a.y; c.bias[2] = a.z; c.bias[3] = a.w; c.bias[4] = b.x; c.bias[5] = b.y; c.bias[6] = b.z; c.bias[7] = b.w;
}
__device__ __forceinline__ void conv8_eval(const Conv8& c, const v4u r0, const v4u r1, const v4u r2, const v4u r3, float (&o)[8]) {
    float f0[8], f1[8], f2[8], f3[8]; unpack8(r0, f0); unpack8(r1, f1); unpack8(r2, f2); unpack8(r3, f3);
#pragma unroll
    for (int e = 0; e < 8; ++e) { const float v = c.bias[e] + c.w[0][e] * f0[e] + c.w[1][e] * f1[e] + c.w[2][e] * f2[e] + c.w[3][e] * f3[e]; o[e] = silu_f(v); }
}
constexpr int SP = 136;

constexpr int S1_XW = 0, S1_BT = 256 * SP * 2, S1_FL = S1_BT + 128 * SP * 2, S1_END = S1_FL + 4224;
static_assert(S1_END <= RING_BYTES, "ssd1 LDS");
__device__ __forceinline__ void ssd_states_unit(Frame& F, int u, const bf16* PROJ, const float* DT, const float* conv_w, const float* conv_b, const float* dt_bias, const float* a_log, float* STATES, float* CD) {
    const int tid = F.tid, lane = F.lane, w = F.wave, fr = lane & 15, g4 = lane >> 4;
    const int b = u >> 6, c = (u >> 1) & 31, g = u & 1, m0 = b * SEQ + 128 * c;
    LAS bf16* Xw = (LAS bf16*)(F.lds + S1_XW); LAS bf16* Bt = (LAS bf16*)(F.lds + S1_BT); LAS float* fl = (LAS float*)(F.lds + S1_FL);
    __syncthreads();
    ssd_dt_acs(F, fl, DT, dt_bias, a_log, m0, g);
    {
        const int l = tid & 127, hh = tid >> 7; const float last = fl[hh * 128 + 127];
        const float wv = __expf(last - fl[hh * 128 + l]) * fl[512 + hh * 128 + l];
        __syncthreads();
        fl[512 + hh * 128 + l] = wv;
        if (l == 127) CD[(size_t)(b * 32 + c) * 8 + 4 * g + hh] = __expf(last);
    }
    __syncthreads();
    if (lane < 48) {
        const int cg = lane; const bool isx = cg < 32; const int hh = cg >> 3;
        const int ch0 = isx ? (4 * g + hh) * 64 + (cg & 7) * 8 : 512 + 128 * g + (cg - 32) * 8;
        Conv8 cv; conv8_load(cv, conv_w, conv_b, ch0);
        const bf16* base = PROJ + (size_t)m0 * NPJ + PC_XBC + ch0;
        const int l0 = 16 * w; const v4u z = {0u, 0u, 0u, 0u};
        v4u r0 = z, r1 = z, r2 = z;
        if (c > 0 || l0 >= 3) { r0 = *(const GAS v4u*)(base + (ptrdiff_t)(l0 - 3) * NPJ); r1 = *(const GAS v4u*)(base + (ptrdiff_t)(l0 - 2) * NPJ); r2 = *(const GAS v4u*)(base + (ptrdiff_t)(l0 - 1) * NPJ); }
#pragma unroll 4
        for (int i = 0; i < 16; ++i) {
            const int l = l0 + i; const v4u r3 = *(const GAS v4u*)(base + (size_t)l * NPJ);
            float o[8]; conv8_eval(cv, r0, r1, r2, r3, o);
            if (isx) { const float wv = fl[512 + hh * 128 + l]; LAS bf16* d = Xw + (hh * 64 + (cg & 7) * 8) * SP + l;
#pragma unroll
                for (int e = 0; e < 8; ++e) d[e * SP] = f2bf16(o[e] * wv); }
            else { LAS bf16* d = Bt + ((cg - 32) * 8) * SP + l;
#pragma unroll
                for (int e = 0; e < 8; ++e) d[e * SP] = f2bf16(o[e]); }
            r0 = r1; r1 = r2; r2 = r3;
        }
    }
    __syncthreads();
    {
        const int hh = w >> 1, nh = w & 1;
        f32x4 acc[4][4];
#pragma unroll
        for (int i = 0; i < 4; ++i)
#pragma unroll
            for (int j = 0; j < 4; ++j) acc[i][j] = (f32x4){0.f, 0.f, 0.f, 0.f};
#pragma unroll
        for (int ks = 0; ks < 4; ++ks) {
            bf16x8 af[4], bfr[4];
#pragma unroll
            for (int i = 0; i < 4; ++i) { af[i] = *(const LAS bf16x8*)(Xw + (hh * 64 + 16 * i + fr) * SP + 32 * ks + 8 * g4); bfr[i] = *(const LAS bf16x8*)(Bt + (64 * nh + 16 * i + fr) * SP + 32 * ks + 8 * g4); }
#pragma unroll
            for (int i = 0; i < 4; ++i)
#pragma unroll
                for (int j = 0; j < 4; ++j) acc[i][j] = __builtin_amdgcn_mfma_f32_16x16x32_bf16(af[i], bfr[j], acc[i][j], 0, 0, 0);
        }
        float* dst = STATES + ((size_t)(b * 32 + c) * 8 + 4 * g + hh) * 8192;
#pragma unroll
        for (int i = 0; i < 4; ++i)
#pragma unroll
            for (int j = 0; j < 4; ++j)
#pragma unroll
                for (int r = 0; r < 4; ++r) dst[(16 * i + 4 * g4 + r) * 128 + 64 * nh + 16 * j + fr] = acc[i][j][r];
    }
}

__device__ __forceinline__ void ssd_scan(Frame& F, const float* STATES, const float* CD, float* HST, float* pssm_l) {
    const int gt = F.vcu * NTHR + F.tid, NT = F.G * NTHR;
    for (int e = gt; e < NBATCH * 65536; e += NT) {
        const int b = e >> 16, hpn = e & 65535, h = hpn >> 13;
        float run = 0.f;
#pragma unroll 8
        for (int c = 0; c < 32; ++c) {
            const size_t idx = (size_t)(b * 32 + c) * 65536 + hpn;
            const float t = STATES[idx]; HST[idx] = run; run = CD[(b * 32 + c) * 8 + h] * run + t;
        }
        pssm_l[(size_t)b * 65536 + hpn] = run;
    }
}

constexpr int S2_CS = 0, S2_BM = 128 * SP * 2, S2_XT = 2 * 128 * SP * 2, S2_HS = S2_XT + 64 * SP * 2, S2_FL = S2_HS + 64 * SP * 2, S2_END = S2_FL + 4224;
static_assert(S2_END <= RING_BYTES, "ssd2 LDS");
__device__ __forceinline__ void ssd_y_unit(Frame& F, int u, const bf16* PROJ, const float* DT, const float* conv_w, const float* conv_b, const float* dt_bias, const float* a_log, const float* dskip,
                                           const float* HST, bf16* CAT, float* SSQ) {
    const int tid = F.tid, lane = F.lane, w = F.wave, fr = lane & 15, g4 = lane >> 4;
    const int b = u >> 6, c = (u >> 1) & 31, g = u & 1, m0 = b * SEQ + 128 * c;
    LAS bf16* Cs = (LAS bf16*)(F.lds + S2_CS); LAS bf16* BM = (LAS bf16*)(F.lds + S2_BM); LAS bf16* Xt = (LAS bf16*)(F.lds + S2_XT); LAS bf16* HS = (LAS bf16*)(F.lds + S2_HS);
    LAS float* fl = (LAS float*)(F.lds + S2_FL);
    __syncthreads();
    ssd_dt_acs(F, fl, DT, dt_bias, a_log, m0, g);
    if (lane < 32) {
        const int cg = lane & 15; const bool isb = lane < 16;
        const int ch0 = (isb ? 512 : 768) + 128 * g + cg * 8;
        Conv8 cv; conv8_load(cv, conv_w, conv_b, ch0);
        const bf16* base = PROJ + (size_t)m0 * NPJ + PC_XBC + ch0;
        const int l0 = 16 * w; const v4u z = {0u, 0u, 0u, 0u};
        v4u r0 = z, r1 = z, r2 = z;
        if (c > 0 || l0 >= 3) { r0 = *(const GAS v4u*)(base + (ptrdiff_t)(l0 - 3) * NPJ); r1 = *(const GAS v4u*)(base + (ptrdiff_t)(l0 - 2) * NPJ); r2 = *(const GAS v4u*)(base + (ptrdiff_t)(l0 - 1) * NPJ); }
        LAS bf16* dbase = (isb ? BM : Cs) + cg * 8;
#pragma unroll 4
        for (int i = 0; i < 16; ++i) {
            const int l = l0 + i; const v4u r3 = *(const GAS v4u*)(base + (size_t)l * NPJ);
            float o[8]; conv8_eval(cv, r0, r1, r2, r3, o);
            v4u pk; pk.x = pk2(o[0], o[1]); pk.y = pk2(o[2], o[3]); pk.z = pk2(o[4], o[5]); pk.w = pk2(o[6], o[7]);
            *(LAS v4u*)(dbase + l * SP) = pk;
            r0 = r1; r1 = r2; r2 = r3;
        }
    }
    __syncthreads();
    f32x4 G[8];
    {
        bf16x8 cf[4];
#pragma unroll
        for (int ks = 0; ks < 4; ++ks) cf[ks] = *(const LAS bf16x8*)(Cs + (16 * w + fr) * SP + 32 * ks + 8 * g4);
#pragma unroll
        for (int st = 0; st < 8; ++st) {
            f32x4 a = {0.f, 0.f, 0.f, 0.f};
            if (st <= w) {
#pragma unroll
                for (int ks = 0; ks < 4; ++ks) { const bf16x8 bfv = *(const LAS bf16x8*)(BM + (16 * st + fr) * SP + 32 * ks + 8 * g4); a = __builtin_amdgcn_mfma_f32_16x16x32_bf16(cf[ks], bfv, a, 0, 0, 0); }
            }
            G[st] = a;
        }
    }
    __syncthreads();
    float ssq[4] = {0.f, 0.f, 0.f, 0.f};
#pragma unroll 1
    for (int hh = 0; hh < 4; ++hh) {
        const int h = 4 * g + hh;
        {
            const int cg = lane & 7, sub = lane >> 3, l0 = 16 * w + 2 * sub, ch0 = h * 64 + cg * 8;
            Conv8 cv; conv8_load(cv, conv_w, conv_b, ch0);
            const bf16* base = PROJ + (size_t)m0 * NPJ + PC_XBC + ch0; const v4u z = {0u, 0u, 0u, 0u};
            v4u r0 = z, r1 = z, r2 = z;
            if (c > 0 || l0 >= 3) { r0 = *(const GAS v4u*)(base + (ptrdiff_t)(l0 - 3) * NPJ); r1 = *(const GAS v4u*)(base + (ptrdiff_t)(l0 - 2) * NPJ); r2 = *(const GAS v4u*)(base + (ptrdiff_t)(l0 - 1) * NPJ); }
            else if (l0 == 2) { r1 = *(const GAS v4u*)(base + (ptrdiff_t)0 * NPJ); r2 = *(const GAS v4u*)(base + (ptrdiff_t)1 * NPJ); }
            const v4u r3 = *(const GAS v4u*)(base + (size_t)l0 * NPJ), r4 = *(const GAS v4u*)(base + (size_t)(l0 + 1) * NPJ);
            float o0[8], o1[8]; conv8_eval(cv, r0, r1, r2, r3, o0); conv8_eval(cv, r1, r2, r3, r4, o1);
            LAS bf16* d = Xt + (cg * 8) * SP + l0;
#pragma unroll
            for (int e = 0; e < 8; ++e) *(LAS unsigned*)(d + e * SP) = pk2(o0[e], o1[e]);
            const int p = tid >> 3, n0 = (tid & 7) * 16;
            const float* hs = HST + ((size_t)(b * 32 + c) * 8 + h) * 8192 + p * 128 + n0;
            const f32x4 a0 = *(const GAS f32x4*)(hs), a1 = *(const GAS f32x4*)(hs + 4), a2 = *(const GAS f32x4*)(hs + 8), a3 = *(const GAS f32x4*)(hs + 12);
            v4u q0, q1; q0.x = pk2(a0.x, a0.y); q0.y = pk2(a0.z, a0.w); q0.z = pk2(a1.x, a1.y); q0.w = pk2(a1.z, a1.w); q1.x = pk2(a2.x, a2.y); q1.y = pk2(a2.z, a2.w); q1.z = pk2(a3.x, a3.y); q1.w = pk2(a3.z, a3.w);
            *(LAS v4u*)(HS + p * SP + n0) = q0; *(LAS v4u*)(HS + p * SP + n0 + 8) = q1;
        }
#pragma unroll
        for (int st = 0; st < 8; ++st) {
#pragma unroll
            for (int r = 0; r < 4; ++r) {
                const int l = 16 * w + 4 * g4 + r, s = 16 * st + fr;
                float v = 0.f;
                if (s <= l) v = G[st][r] * __expf(fl[hh * 128 + l] - fl[hh * 128 + s]) * fl[512 + hh * 128 + s];
                BM[l * SP + s] = f2bf16(v);
            }
        }
        __syncthreads();
        f32x4 yd[4], yo[4];
#pragma unroll
        for (int pt = 0; pt < 4; ++pt) { yd[pt] = (f32x4){0.f, 0.f, 0.f, 0.f}; yo[pt] = (f32x4){0.f, 0.f, 0.f, 0.f}; }
#pragma unroll
        for (int ks = 0; ks < 4; ++ks) {
            const bf16x8 mf = *(const LAS bf16x8*)(BM + (16 * w + fr) * SP + 32 * ks + 8 * g4);
            const bf16x8 cf = *(const LAS bf16x8*)(Cs + (16 * w + fr) * SP + 32 * ks + 8 * g4);
#pragma unroll
            for (int pt = 0; pt < 4; ++pt) {
                const bf16x8 xf = *(const LAS bf16x8*)(Xt + (16 * pt + fr) * SP + 32 * ks + 8 * g4);
                const bf16x8 hf = *(const LAS bf16x8*)(HS + (16 * pt + fr) * SP + 32 * ks + 8 * g4);
                yd[pt] = __builtin_amdgcn_mfma_f32_16x16x32_bf16(mf, xf, yd[pt], 0, 0, 0);
                yo[pt] = __builtin_amdgcn_mfma_f32_16x16x32_bf16(cf, hf, yo[pt], 0, 0, 0);
            }
        }
        const float dsk = dskip[h];
#pragma unroll
        for (int r = 0; r < 4; ++r) {
            const int l = 16 * w + 4 * g4 + r; const float ea = __expf(fl[hh * 128 + l]);
#pragma unroll
            for (int pt = 0; pt < 4; ++pt) {
                const int p = 16 * pt + fr;
                const float xv = bf2f(Xt[p * SP + l]);
                const float y = yd[pt][r] + ea * yo[pt][r] + dsk * xv;
                const float zv = bf2f(PROJ[(size_t)(m0 + l) * NPJ + PC_Z + h * 64 + p]);
                const float yg = y * silu_f(zv);
                CAT[(size_t)(m0 + l) * DM + 256 + h * 64 + p] = f2bf16(yg);
                ssq[r] += yg * yg;
            }
        }
        __syncthreads();
    }
#pragma unroll
    for (int r = 0; r < 4; ++r) {
#pragma unroll
        for (int o = 1; o < 16; o <<= 1) ssq[r] += __shfl_xor(ssq[r], o);
        if (fr == 0) SSQ[(size_t)(m0 + 16 * w + 4 * g4 + r) * 8 + g] = ssq[r];
    }
}

__device__ __forceinline__ void attn_sample_unit(Frame& F, int u, int layer, const bf16* PROJ, const float* cache_k, const float* cache_v, bf16* OPART, float* MLM, float* MLL) {
    const int lane = F.lane, s = F.wave, b = u >> 2, h = u & 3;
    const size_t m = (size_t)TP + 8 * b + s;
    LAS float* Pl = (LAS float*)(F.lds + RING_OFF) + s * 448;
    __syncthreads();
    float q[64];
    {
        const bf16* qp = PROJ + m * NPJ + PC_Q + h * 64;
#pragma unroll
        for (int i = 0; i < 8; ++i) { const v4u w4 = *(const GAS v4u*)(qp + 8 * i); float f[8]; unpack8(w4, f);
#pragma unroll
            for (int e = 0; e < 8; ++e) q[8 * i + e] = f[e]; }
    }
    const float slope = exp2f(-2.f * (float)(h + 1));
    const float* ck = cache_k + ((size_t)(layer * DBATCH + b) * WBUF) * 256 + h * 64;
    const float* cv = cache_v + ((size_t)(layer * DBATCH + b) * WBUF) * 256 + h * 64;
    const bf16* nk = PROJ + ((size_t)TP + 8 * b) * NPJ + PC_K + h * 64;
    const bf16* nv = PROJ + ((size_t)TP + 8 * b) * NPJ + PC_V + h * 64;
    float sc[7]; float mxv = -INFINITY;
#pragma unroll
    for (int it = 0; it < 7; ++it) {
        const int kk = lane + 64 * it; float v = -INFINITY;
        if (kk < 387) {
            const int br = kk / 129, j = kk - 129 * br, dil = 1 << (2 * br), idx = WBUF + s - dil * j;
            float dot = 0.f;
            if (idx < WBUF) { const float* kp = ck + (size_t)idx * 256;
#pragma unroll
                for (int i = 0; i < 16; ++i) { const f32x4 kv = *(const GAS f32x4*)(kp + 4 * i); dot += q[4 * i] * kv.x + q[4 * i + 1] * kv.y + q[4 * i + 2] * kv.z + q[4 * i + 3] * kv.w; } }
            else { const bf16* kp = nk + (size_t)(idx - WBUF) * NPJ;
#pragma unroll
                for (int i = 0; i < 8; ++i) { const v4u w4 = *(const GAS v4u*)(kp + 8 * i); float f[8]; unpack8(w4, f);
#pragma unroll
                    for (int e = 0; e < 8; ++e) dot += q[8 * i + e] * f[e]; } }
            v = dot * 0.125f - slope * (float)(dil * j);
        }
        sc[it] = v; mxv = fmaxf(mxv, v);
    }
    mxv = wave_max(mxv);
    float lsum = 0.f;
#pragma unroll
    for (int it = 0; it < 7; ++it) { const int kk = lane + 64 * it; const float p = __expf(sc[it] - mxv); if (kk < 387) { Pl[kk] = p; lsum += p; } }
    lsum = wave_sum(lsum);
    LDS_WAIT(); asm volatile("" ::: "memory");
    float o = 0.f;
#pragma unroll 1
    for (int br = 0; br < 3; ++br) {
        const int dil = 1 << (2 * br);
#pragma unroll 4
        for (int j = 0; j < 129; ++j) {
            const int idx = WBUF + s - dil * j; const float p = Pl[129 * br + j];
            const float vv = (idx < WBUF) ? cv[(size_t)idx * 256 + lane] : bf2f(nv[(size_t)(idx - WBUF) * NPJ + lane]);
            o += p * vv;
        }
    }
    o /= lsum;
    OPART[m * 768 + h * 64 + lane] = f2bf16(o); OPART[m * 768 + 256 + h * 64 + lane] = (bf16)0; OPART[m * 768 + 512 + h * 64 + lane] = (bf16)0;
    if (lane < 3) { MLM[m * 12 + lane * 4 + h] = 0.f; MLL[m * 12 + lane * 4 + h] = (lane == 0) ? 1.f : 0.f; }
}

__device__ __forceinline__ void ssd_sample_unit(Frame& F, int u, int layer, const bf16* PROJ, const float* DT, const float* st_ssm, const float* st_conv, const float* conv_w, const float* conv_b,
                                                const float* dt_bias, const float* a_log, const float* dskip, bf16* CAT, float* SSQ, float* out_ssm_l, float* out_conv_l) {
    const int tid = F.tid, b = u >> 3, h = u & 7, g = h >> 2;
    LAS float* xs = (LAS float*)(F.lds + RING_OFF); LAS float* Bs = xs + 8 * 64; LAS float* Cs = Bs + 8 * 128; LAS float* dts = Cs + 8 * 128; LAS float* ysq = dts + 8;
    __syncthreads();
#pragma unroll 1
    for (int k = 0; k < 5; ++k) {
        const int i = tid + 512 * k, s = i / 320, ci = i - 320 * s;
        const int ch = (ci < 64) ? 64 * h + ci : (ci < 192) ? 512 + 128 * g + (ci - 64) : 768 + 128 * g + (ci - 192);
        float acc = conv_b[ch];
#pragma unroll
        for (int t = 0; t < 4; ++t) {
            const int e = s + t;
            const float v = (e < 3) ? st_conv[((size_t)(layer * DBATCH + b) * 3 + e) * 1024 + ch] : bf2f(PROJ[((size_t)TP + 8 * b + e - 3) * NPJ + PC_XBC + ch]);
            acc += conv_w[t * 1024 + ch] * v;
        }
        const float o = silu_f(acc);
        if (ci < 64) xs[s * 64 + ci] = o; else if (ci < 192) Bs[s * 128 + ci - 64] = o; else Cs[s * 128 + ci - 192] = o;
    }
    if (tid < 8) dts[tid] = softplus_f(DT[((size_t)TP + 8 * b + tid) * 8 + h] + dt_bias[h]);
    if (h == 0) { for (int i = tid; i < 3 * 1024; i += NTHR) { const int k = i >> 10, ch = i & 1023; out_conv_l[((size_t)b * 3 + k) * 1024 + ch] = bf2f(PROJ[((size_t)TP + 8 * b + 5 + k) * NPJ + PC_XBC + ch]); } }
    __syncthreads();
    const int p = tid >> 3, nq = tid & 7;
    float hr[16];
    const float* h0 = st_ssm + ((size_t)(layer * DBATCH + b) * 8 + h) * 8192 + p * 128 + 16 * nq;
#pragma unroll
    for (int i = 0; i < 4; ++i) { const f32x4 v = *(const GAS f32x4*)(h0 + 4 * i); hr[4 * i] = v.x; hr[4 * i + 1] = v.y; hr[4 * i + 2] = v.z; hr[4 * i + 3] = v.w; }
    const float a = -__expf(a_log[h]), dsk = dskip[h];
#pragma unroll 1
    for (int s = 0; s < 8; ++s) {
        const float dtv = dts[s], dec = __expf(dtv * a), xv = xs[s * 64 + p], coef = dtv * xv;
        float yp = 0.f;
#pragma unroll
        for (int i = 0; i < 16; ++i) { hr[i] = dec * hr[i] + coef * Bs[s * 128 + 16 * nq + i]; yp += Cs[s * 128 + 16 * nq + i] * hr[i]; }
        yp += __shfl_xor(yp, 1); yp += __shfl_xor(yp, 2); yp += __shfl_xor(yp, 4);
        if (nq == 0) {
            const size_t m = (size_t)TP + 8 * b + s;
            const float y = yp + dsk * xv, zv = bf2f(PROJ[m * NPJ + PC_Z + 64 * h + p]), yg = y * silu_f(zv);
            CAT[m * DM + 256 + 64 * h + p] = f2bf16(yg); ysq[s * 64 + p] = yg * yg;
        }
    }
    float* hout = out_ssm_l + ((size_t)b * 8 + h) * 8192 + p * 128 + 16 * nq;
#pragma unroll
    for (int i = 0; i < 4; ++i) *(GAS f32x4*)(hout + 4 * i) = (f32x4){hr[4 * i], hr[4 * i + 1], hr[4 * i + 2], hr[4 * i + 3]};
    __syncthreads();
    if (tid < 8) { float t = 0.f; for (int i = 0; i < 64; ++i) t += ysq[tid * 64 + i]; SSQ[((size_t)TP + 8 * b + tid) * 8 + h] = t; }
}

__device__ __forceinline__ void copy_outputs(Frame& F, int layer, const bf16* PROJ, float* out) {
    const int gt = F.vcu * NTHR + F.tid, NT = F.G * NTHR;
    for (int i = gt; i < NBATCH * WBUF * 64; i += NT) {
        const int c8 = i & 63, row = i >> 6, b = row >> 11, ii = row & 2047;
        const v4u w4 = *(const GAS v4u*)(PROJ + ((size_t)b * SEQ + 2048 + ii) * NPJ + PC_K + c8 * 8); float f[8]; unpack8(w4, f);
        float* dst = out + ((c8 < 32) ? O_PK : O_PV) + ((size_t)(layer * NBATCH + b) * WBUF + ii) * 256 + (c8 & 31) * 8;
        *(GAS f32x4*)dst = (f32x4){f[0], f[1], f[2], f[3]}; *(GAS f32x4*)(dst + 4) = (f32x4){f[4], f[5], f[6], f[7]};
    }
    for (int i = gt; i < TS * 64; i += NT) {
        const int c8 = i & 63, row = i >> 6, b = row >> 3, s = row & 7;
        const v4u w4 = *(const GAS v4u*)(PROJ + ((size_t)TP + row) * NPJ + PC_K + c8 * 8); float f[8]; unpack8(w4, f);
        float* dst = out + ((c8 < 32) ? O_SK : O_SV) + ((size_t)(layer * DBATCH + b) * WBUF + 2040 + s) * 256 + (c8 & 31) * 8;
        *(GAS f32x4*)dst = (f32x4){f[0], f[1], f[2], f[3]}; *(GAS f32x4*)(dst + 4) = (f32x4){f[4], f[5], f[6], f[7]};
    }
    for (int i = gt; i < NBATCH * 3 * 128; i += NT) {
        const int c8 = i & 127, rk = i >> 7, b = rk / 3, k = rk - 3 * b;
        const v4u w4 = *(const GAS v4u*)(PROJ + ((size_t)b * SEQ + 4093 + k) * NPJ + PC_XBC + c8 * 8); float f[8]; unpack8(w4, f);
        float* dst = out + O_PCONV + ((size_t)(layer * NBATCH + b) * 3 + k) * 1024 + c8 * 8;
        *(GAS f32x4*)dst = (f32x4){f[0], f[1], f[2], f[3]}; *(GAS f32x4*)(dst + 4) = (f32x4){f[4], f[5], f[6], f[7]};
    }
}

__device__ __forceinline__ void finalize_rows(Frame& F, int layer, const bf16* PROJ, const bf16* OPART, const float* MLM, const float* MLL, const float* SSQ, bf16* CAT,
                                              const float* attn_norm, const float* ssm_norm, const float* sconv_w, const float* sconv_norm, const float* st_sconv, float* out) {
    const int gw = F.vcu * NWAVES + F.wave, NGW = F.G * NWAVES, lane = F.lane;
    for (int m = gw; m < MT; m += NGW) {
        const bool samp = m >= TP;
        {
            const int h = lane >> 4;
            float mb[3], lb[3]; float M = -INFINITY;
#pragma unroll
            for (int br = 0; br < 3; ++br) { mb[br] = MLM[(size_t)m * 12 + br * 4 + h]; lb[br] = MLL[(size_t)m * 12 + br * 4 + h]; if (lb[br] > 0.f) M = fmaxf(M, mb[br]); }
            float o[4] = {0.f, 0.f, 0.f, 0.f}; float wsum = 0.f;
#pragma unroll
            for (int br = 0; br < 3; ++br) {
                const float wgt = (lb[br] > 0.f) ? lb[br] * __expf(mb[br] - M) : 0.f; wsum += wgt;
                const unsigned long long pk = *(const GAS unsigned long long*)(OPART + (size_t)m * 768 + br * 256 + 4 * lane);
                const unsigned lo = (unsigned)pk, hi = (unsigned)(pk >> 32);
                o[0] += wgt * bflo(lo); o[1] += wgt * bfhi(lo); o[2] += wgt * bflo(hi); o[3] += wgt * bfhi(hi);
            }
            const float iw = 1.f / wsum; float ss = 0.f;
#pragma unroll
            for (int e = 0; e < 4; ++e) { o[e] *= iw; ss += o[e] * o[e]; }
            const float r = 1.f / sqrtf(wave_sum(ss) * (1.f / 256.f) + EPS);
            const f32x4 gg = *(const GAS f32x4*)(attn_norm + 4 * lane);
            *(GAS unsigned long long*)(CAT + (size_t)m * DM + 4 * lane) = (unsigned long long)pk2(o[0] * r * gg.x, o[1] * r * gg.y) | ((unsigned long long)pk2(o[2] * r * gg.z, o[3] * r * gg.w) << 32);
        }
        {
            float tot = 0.f;
            if (samp) { for (int i = 0; i < 8; ++i) tot += SSQ[(size_t)m * 8 + i]; } else tot = SSQ[(size_t)m * 8] + SSQ[(size_t)m * 8 + 1];
            const float r = 1.f / sqrtf(tot * (1.f / 512.f) + EPS);
            GAS v4u* p = (GAS v4u*)(CAT + (size_t)m * DM + 256 + 8 * lane);
            const v4u w4 = *p; float f[8]; unpack8(w4, f);
            const f32x4 g0 = *(const GAS f32x4*)(ssm_norm + 8 * lane), g1 = *(const GAS f32x4*)(ssm_norm + 8 * lane + 4);
            v4u o; o.x = pk2(f[0] * r * g0.x, f[1] * r * g0.y); o.y = pk2(f[2] * r * g0.z, f[3] * r * g0.w); o.z = pk2(f[4] * r * g1.x, f[5] * r * g1.y); o.w = pk2(f[6] * r * g1.z, f[7] * r * g1.w);
            *p = o;
        }
        {
            const int ch = 4 * lane;
            float uu[3][4];
            int b, t; if (samp) { b = (m - TP) >> 3; t = (m - TP) & 7; } else { b = m >> 12; t = m & 4095; }
#pragma unroll
            for (int k = 0; k < 3; ++k) {
                const int tt = t - 2 + k;
                if (tt >= 0) {
                    const bf16* pr = PROJ + (size_t)(m - 2 + k) * NPJ;
                    const unsigned long long cgp = *(const GAS unsigned long long*)(pr + PC_CG + ch), ucp = *(const GAS unsigned long long*)(pr + PC_UC + ch);
                    uu[k][0] = bflo((unsigned)cgp) * bflo((unsigned)ucp); uu[k][1] = bfhi((unsigned)cgp) * bfhi((unsigned)ucp);
                    uu[k][2] = bflo((unsigned)(cgp >> 32)) * bflo((unsigned)(ucp >> 32)); uu[k][3] = bfhi((unsigned)(cgp >> 32)) * bfhi((unsigned)(ucp >> 32));
                } else if (samp) {
                    const f32x4 v = *(const GAS f32x4*)(st_sconv + ((size_t)(layer * DBATCH + b) * 2 + (tt + 2)) * 256 + ch);
                    uu[k][0] = v.x; uu[k][1] = v.y; uu[k][2] = v.z; uu[k][3] = v.w;
                } else { uu[k][0] = 0.f; uu[k][1] = 0.f; uu[k][2] = 0.f; uu[k][3] = 0.f; }
            }
            const f32x4 w0 = *(const GAS f32x4*)(sconv_w + ch), w1 = *(const GAS f32x4*)(sconv_w + 256 + ch), w2 = *(const GAS f32x4*)(sconv_w + 512 + ch);
            const unsigned long long bgp = *(const GAS unsigned long long*)(PROJ + (size_t)m * NPJ + PC_BG + ch);
            float v[4];
            v[0] = bflo((unsigned)bgp) * (w0.x * uu[0][0] + w1.x * uu[1][0] + w2.x * uu[2][0]);
            v[1] = bfhi((unsigned)bgp) * (w0.y * uu[0][1] + w1.y * uu[1][1] + w2.y * uu[2][1]);
            v[2] = bflo((unsigned)(bgp >> 32)) * (w0.z * uu[0][2] + w1.z * uu[1][2] + w2.z * uu[2][2]);
            v[3] = bfhi((unsigned)(bgp >> 32)) * (w0.w * uu[0][3] + w1.w * uu[1][3] + w2.w * uu[2][3]);
            const float ss = v[0] * v[0] + v[1] * v[1] + v[2] * v[2] + v[3] * v[3];
            const float r = 1.f / sqrtf(wave_sum(ss) * (1.f / 256.f) + EPS);
            const f32x4 gg = *(const GAS f32x4*)(sconv_norm + ch);
            *(GAS unsigned long long*)(CAT + (size_t)m * DM + 768 + ch) = (unsigned long long)pk2(v[0] * r * gg.x, v[1] * r * gg.y) | ((unsigned long long)pk2(v[2] * r * gg.z, v[3] * r * gg.w) << 32);
            if (!samp && t >= SEQ - 2) *(GAS f32x4*)(out + O_PSC + ((size_t)(layer * NBATCH + b) * 2 + (t - (SEQ - 2))) * 256 + ch) = (f32x4){uu[2][0], uu[2][1], uu[2][2], uu[2][3]};
            if (samp && t >= DSEQ - 2) *(GAS f32x4*)(out + O_SSC + ((size_t)(layer * DBATCH + b) * 2 + (t - (DSEQ - 2))) * 256 + ch) = (f32x4){uu[2][0], uu[2][1], uu[2][2], uu[2][3]};
        }
    }
}

__device__ __forceinline__ void resid_norm_rows(Frame& F, const float* MIX, float* X, bf16* XN, const float* g1, const float* g2  ) {
    const int gw = F.vcu * NWAVES + F.wave, NGW = F.G * NWAVES, lane = F.lane;
    for (int m = gw; m < MT; m += NGW) {
        const GAS f32x4* mr = (const GAS f32x4*)(MIX + (size_t)m * DM) + lane; GAS f32x4* xr = (GAS f32x4*)(X + (size_t)m * DM) + lane;
        f32x4 v[4], x[4]; float s = 0.f;
#pragma unroll
        for (int j = 0; j < 4; ++j) { v[j] = mr[64 * j]; x[j] = xr[64 * j]; s += (v[j].x * v[j].x + v[j].y * v[j].y) + (v[j].z * v[j].z + v[j].w * v[j].w); }
        const float r = 1.f / sqrtf(wave_sum(s) * (1.f / DM) + EPS);
        float s2 = 0.f;
#pragma unroll
        for (int j = 0; j < 4; ++j) { const f32x4 gg = ((const GAS f32x4*)g1 + lane)[64 * j];
            x[j].x += v[j].x * r * gg.x; x[j].y += v[j].y * r * gg.y; x[j].z += v[j].z * r * gg.z; x[j].w += v[j].w * r * gg.w;
            xr[64 * j] = x[j]; s2 += (x[j].x * x[j].x + x[j].y * x[j].y) + (x[j].z * x[j].z + x[j].w * x[j].w); }
        if (g2) {
            const float r2 = 1.f / sqrtf(wave_sum(s2) * (1.f / DM) + EPS);
            GAS unsigned long long* o8 = (GAS unsigned long long*)(XN + (size_t)m * DM) + lane;
#pragma unroll
            for (int j = 0; j < 4; ++j) { const f32x4 gg = ((const GAS f32x4*)g2 + lane)[64 * j];
                o8[64 * j] = (unsigned long long)pk2(x[j].x * r2 * gg.x, x[j].y * r2 * gg.y) | ((unsigned long long)pk2(x[j].z * r2 * gg.z, x[j].w * r2 * gg.w) << 32); }
        }
    }
}

struct Args { const float* in[24]; float* out; unsigned char* ws; };
typedef __attribute__((address_space(4))) const Args* KArgs;
#define PHASE_PTRS() \
    KArgs A_ = (KArgs)__builtin_amdgcn_kernarg_segment_ptr(); asm volatile("" : "+s"(A_)); \
    Frame F; { int t_ = threadIdx.x; asm volatile("" : "+v"(t_)); F.tid = t_; F.lane = t_ & 63; F.wave = __builtin_amdgcn_readfirstlane(t_ >> 6); F.lds = (LAS unsigned char*)lds; \
      F.MISC = (volatile LAS unsigned*)(F.lds + MISC_OFF); F.G = gridDim.x; const int bx_ = blockIdx.x; F.vcu = (F.G % 8 == 0) ? (bx_ % 8) * (F.G / 8) + bx_ / 8 : bx_; F.ctl = (gu32*)(A_->ws + WS_CTL); } \
    unsigned char* ws = A_->ws; float* out = A_->out; (void)out; \
    float* X = out + O_Y; (void)X; \
    bf16* XN = (bf16*)(ws + WS_XN); bf16* PROJ = (bf16*)(ws + WS_PROJ); bf16* CAT = (bf16*)(ws + WS_CAT); float* MIX = (float*)(ws + WS_MIX); bf16* HB = (bf16*)(ws + WS_H); \
    bf16* OPART = (bf16*)(ws + WS_OPART); float* MLM = (float*)(ws + WS_MLM); float* MLL = (float*)(ws + WS_MLL); float* DT = (float*)(ws + WS_DT); float* SSQ = (float*)(ws + WS_SSQ); \
    float* CD = (float*)(ws + WS_CD); float* STATES = (float*)(ws + WS_STATES); float* HST = (float*)(ws + WS_HST); \
    (void)XN; (void)PROJ; (void)CAT; (void)MIX; (void)HB; (void)OPART; (void)MLM; (void)MLL; (void)DT; (void)SSQ; (void)CD; (void)STATES; (void)HST; \
    const bf16* Win = (const bf16*)(ws + WS_WIN + (size_t)layer * SZ_WIN); const bf16* Wout = (const bf16*)(ws + WS_WOUT + (size_t)layer * SZ_WOUT); \
    const bf16* Wup = (const bf16*)(ws + WS_WUP + (size_t)layer * SZ_WUP); const bf16* Wdn = (const bf16*)(ws + WS_WDN + (size_t)layer * SZ_WDN); \
    (void)Win; (void)Wout; (void)Wup; (void)Wdn
#define IN_(i) (A_->in[i])

__global__ void __launch_bounds__(NTHR, 2) hymba_fwd(Args args) {
    extern __shared__ __attribute__((aligned(16))) unsigned char lds[];
    for (int u = threadIdx.x; u < (LDS_BYTES - LDSCTL_OFF) / 4; u += NTHR) ((LAS unsigned*)((LAS unsigned char*)lds + LDSCTL_OFF))[u] = 0u;
    __syncthreads();
    XcdBarrier bar = xcd_barrier_post((unsigned*)((gu32*)(args.ws + WS_CTL) + CW_BAR), (volatile LAS unsigned*)((LAS unsigned char*)lds + MISC_OFF) + 8);
#define GRID_BAR() xcd_barrier(bar)
#ifndef PHM
#define PHM 0xFFFF
#endif

    if (PHM & 1) {
        const int layer = 0; PHASE_PTRS();
        Ptrs P;
        P.x_prompt = IN_(0); P.x_sample = IN_(1); P.cache_k = IN_(2); P.cache_v = IN_(3); P.g_mix_pre = IN_(7); P.w_in = IN_(11); P.w_out = IN_(12); P.w_up = IN_(22); P.w_down = IN_(23); P.out = out; P.ws = ws;
        p0_prologue(F, P);
    }
    GRID_BAR();

#pragma unroll 1
    for (int layer = 0; layer < DEPTH; ++layer) {
        if (PHM & 2) {
            PHASE_PTRS();
            pg8::Gemm g{XN, Win, MT, NPJ, DM}; pg8::StaticOrder S; S.init(MT, NPJ, F.G, (int)blockIdx.x);
            pg8::EpiBf16<0> E{PROJ, NPJ};
            pg8::gemm_phase<pg8::EpiBf16<0>, pg8::StaticOrder, true, true>(F.lds + RING_OFF, g, S, E);
            dt_pass(F, XN, Win + (size_t)NPJ * DM, DT);
        }
        GRID_BAR();
        {
            PHASE_PTRS();
            const float* conv_w = IN_(14) + (size_t)layer * 4 * 1024; const float* conv_b = IN_(15) + (size_t)layer * 1024;
            const float* a_log = IN_(16) + layer * 8; const float* dt_bias = IN_(17) + layer * 8; const float* dskip = IN_(18) + layer * 8;
            if (PHM & 4) for (int u = F.vcu; u < 1536; u += F.G) attn_prompt_unit(F, u, PROJ, OPART, MLM, MLL);
            if (PHM & 8) for (int u = F.vcu; u < 256; u += F.G) ssd_states_unit(F, u, PROJ, DT, conv_w, conv_b, dt_bias, a_log, STATES, CD);
            if (PHM & 16) for (int u = F.vcu; u < 128; u += F.G) attn_sample_unit(F, u, layer, PROJ, IN_(2), IN_(3), OPART, MLM, MLL);
            if (PHM & 32) for (int u = F.vcu; u < 256; u += F.G) ssd_sample_unit(F, u, layer, PROJ, DT, IN_(4), IN_(5), conv_w, conv_b, dt_bias, a_log, dskip, CAT, SSQ,
                                                                   out + O_SSSM + (size_t)layer * DBATCH * 65536, out + O_SCONV + (size_t)layer * DBATCH * 3072);
            if (PHM & 64) copy_outputs(F, layer, PROJ, out);
        }
        GRID_BAR();
        if (PHM & 128) { PHASE_PTRS(); ssd_scan(F, STATES, CD, HST, out + O_PSSM + (size_t)layer * NBATCH * 65536); }
        GRID_BAR();
        if (PHM & 256) {
            PHASE_PTRS();
            const float* conv_w = IN_(14) + (size_t)layer * 4 * 1024; const float* conv_b = IN_(15) + (size_t)layer * 1024;
            const float* a_log = IN_(16) + layer * 8; const float* dt_bias = IN_(17) + layer * 8; const float* dskip = IN_(18) + layer * 8;
            for (int u = F.vcu; u < 256; u += F.G) ssd_y_unit(F, u, PROJ, DT, conv_w, conv_b, dt_bias, a_log, dskip, HST, CAT, SSQ);
        }
        GRID_BAR();
        if (PHM & 512) { PHASE_PTRS(); finalize_rows(F, layer, PROJ, OPART, MLM, MLL, SSQ, CAT, IN_(13) + layer * 256, IN_(19) + layer * 512, IN_(20) + layer * 768, IN_(21) + layer * 256, IN_(6), out); }
        GRID_BAR();
        if (PHM & 1024) {
            PHASE_PTRS();
            pg8::Gemm g{CAT, Wout, MT, DM, DM}; pg8::StaticOrder S; S.init(MT, DM, F.G, (int)blockIdx.x);
            pg8::EpiF32 E{MIX, DM};
            pg8::gemm_phase<pg8::EpiF32, pg8::StaticOrder, true, true>(F.lds + RING_OFF, g, S, E);
        }
        GRID_BAR();
        if (PHM & 2048) { PHASE_PTRS(); resid_norm_rows(F, MIX, X, XN, IN_(8) + layer * DM, IN_(9) + layer * DM); }
        GRID_BAR();
        if (PHM & 4096) {
            PHASE_PTRS();
            pg8::Gemm g{XN, Wup, MT, DFF, DM}; pg8::StaticOrder S; S.init(MT, DFF, F.G, (int)blockIdx.x);
            pg8::EpiBf16<2> E{HB, DFF};
            pg8::gemm_phase<pg8::EpiBf16<2>, pg8::StaticOrder, true, true>(F.lds + RING_OFF, g, S, E);
        }
        GRID_BAR();
        if (PHM & 8192) {
            PHASE_PTRS();
            pg8::Gemm g{HB, Wdn, MT, DM, DFF}; pg8::StaticOrder S; S.init(MT, DM, F.G, (int)blockIdx.x);
            pg8::EpiF32 E{MIX, DM};
            pg8::gemm_phase<pg8::EpiF32, pg8::StaticOrder, true, true>(F.lds + RING_OFF, g, S, E);
        }
        GRID_BAR();
        if (PHM & 16384) { PHASE_PTRS(); resid_norm_rows(F, MIX, X, XN, IN_(10) + layer * DM, (layer + 1 < DEPTH) ? IN_(7) + (layer + 1) * DM : nullptr); }
        if (layer + 1 < DEPTH) GRID_BAR();
    }
}

extern "C" void kernel_launch(void* const* d_in, const int* in_sizes, int n_in, void* d_out, int out_size, void* d_ws, size_t ws_size, hipStream_t stream) {
    static int grid = 0;
    if (grid == 0) {
        if (n_in != 24 || (size_t)out_size != O_END || ws_size < WS_END) { fprintf(stderr, "kernel_launch: unexpected shapes n_in %d out %d ws %zu\n", n_in, out_size, ws_size); grid = -1; return; }
        int dev = 0, cus = 0, per_cu = 0;
        if (hipGetDevice(&dev) != hipSuccess || hipDeviceGetAttribute(&cus, hipDeviceAttributeMultiprocessorCount, dev) != hipSuccess) { grid = -1; return; }
        if (hipFuncSetAttribute((const void*)hymba_fwd, hipFuncAttributeMaxDynamicSharedMemorySize, LDS_BYTES) != hipSuccess) { fprintf(stderr, "kernel_launch: hipFuncSetAttribute failed\n"); grid = -1; return; }
        if (hipOccupancyMaxActiveBlocksPerMultiprocessor(&per_cu, (const void*)hymba_fwd, NTHR, LDS_BYTES) != hipSuccess || per_cu < 1) fprintf(stderr, "kernel_launch: occupancy query reports %d\n", per_cu);
        (void)hipGetLastError();
        grid = cus;
    }
    if (grid < 0) return;
    if (hipMemsetAsync((char*)d_ws + WS_CTL, 0, CTL_ZERO_BYTES, stream) != hipSuccess) return;
    Args a{};
    for (int i = 0; i < 24; ++i) a.in[i] = (const float*)d_in[i];
    a.out = (float*)d_out; a.ws = (unsigned char*)d_ws;
    hipLaunchKernelGGL(hymba_fwd, dim3(grid), dim3(NTHR), LDS_BYTES, stream, a);
}
```
